# Optimizing an MI355X kernel written in HIP

```python
import math
import jax, jax.numpy as jnp
from jax import lax
import numpy as np

D_MODEL = 1024
BATCH = 4
SEQ = 8192
DEPTH = 2

BLOCK = 128
HEAD_DIM = 64
A_HEADS = 4
A_QK = 32
A_V = 2 * A_QK
B_QHEADS = 4
B_KVHEADS = 2
B_WINDOW = 128
C_PATTERNS = ((128, 1), (512, 4), (2048, 16))
C_HEADS = 4
D_HEADS = 4
D_TOPK_MAX = 256
IDX_HEADS = 8
IDX_DIM = 32
REL_BUCKETS = 32
REL_MAX_DIST = 2048
A_BIAS0 = 0
B_BIAS0 = A_BIAS0 + A_HEADS
C_BIAS0 = B_BIAS0 + B_QHEADS
D_BIAS0 = C_BIAS0 + len(C_PATTERNS) * C_HEADS
N_BIAS_HEADS = D_BIAS0 + D_HEADS
N_BRANCH = 4
BRANCH_WIDTH = 256
N_EXPERTS = 16
N_GROUPS = 4
EXPERTS_PER_GROUP = N_EXPERTS // N_GROUPS
TOP_K = 2
GROUP_SCORE_TOPK = 2
D_FF_EXPERT = 256
MOE_BLOCK = 128
DEEPNORM_ALPHA = (2 * DEPTH) ** 0.25
DEEPNORM_BETA = (8 * DEPTH) ** -0.25

IN_SPLITS = (
    ('a_q', A_HEADS * 2 * A_QK), ('a_k', A_HEADS * 2 * A_QK), ('a_v', A_HEADS * A_V),
    ('b_q', B_QHEADS * HEAD_DIM), ('b_k', B_KVHEADS * HEAD_DIM), ('b_v', B_KVHEADS * HEAD_DIM),
    ('c_q', len(C_PATTERNS) * C_HEADS * HEAD_DIM), ('c_k', len(C_PATTERNS) * C_HEADS * HEAD_DIM),
    ('c_v', len(C_PATTERNS) * C_HEADS * HEAD_DIM),
    ('d_q', D_HEADS * HEAD_DIM), ('d_k', HEAD_DIM), ('d_v', HEAD_DIM),
    ('i_q', IDX_HEADS * IDX_DIM), ('i_k', IDX_DIM), ('i_w', IDX_HEADS),
    ('gate', N_BRANCH * D_MODEL),
)
IN_WIDTH = sum(w for _, w in IN_SPLITS)

kernel_name = 'hybrid_gated_four_mixer_deepnorm_moe'


def layer_norm(x, g, b, eps=1e-5):
    xf = x.astype(jnp.float32)
    mu = jnp.mean(xf, axis=-1, keepdims=True)
    var = jnp.mean(jnp.square(xf - mu), axis=-1, keepdims=True)
    return ((xf - mu) * lax.rsqrt(var + eps)).astype(x.dtype) * g + b


def rms_norm(x, g, eps=1e-5):
    xf = x.astype(jnp.float32)
    return (xf * lax.rsqrt(jnp.mean(jnp.square(xf), axis=-1, keepdims=True) + eps)).astype(x.dtype) * g


def t5_bucket(n):
    max_exact = REL_BUCKETS // 2
    nf = jnp.maximum(n, 1).astype(jnp.float32)
    log_ratio = jnp.log(nf / max_exact) / math.log(REL_MAX_DIST / max_exact)
    large = max_exact + (log_ratio * (REL_BUCKETS - max_exact)).astype(jnp.int32)
    large = jnp.minimum(large, REL_BUCKETS - 1)
    return jnp.where(n < max_exact, n, large)


def rel_bias(rel_table, dist, h0, nh):
    return rel_table[:, h0:h0 + nh].astype(jnp.float32)[t5_bucket(jnp.maximum(dist, 0))]


def split_in(h):
    parts = {}
    off = 0
    for name, width in IN_SPLITS:
        parts[name] = h[..., off:off + width]
        off += width
    return parts


def diff_attention(q, k, v, lam_q, lam_k, subln_g, rel_table, layer_idx):
    bsz, seq, _ = q.shape
    nb = seq // BLOCK
    qb = jnp.moveaxis(q.reshape(bsz, nb, BLOCK, A_HEADS, 2, A_QK), 1, 0)
    k = k.reshape(bsz, seq, A_HEADS, 2, A_QK)
    v = v.reshape(bsz, seq, A_HEADS, A_V)
    lam_init = 0.8 - 0.6 * math.exp(-0.3 * layer_idx)
    lq = lam_q.astype(jnp.float32)
    lk = lam_k.astype(jnp.float32)
    lam = jnp.exp(jnp.sum(lq[0] * lk[0])) - jnp.exp(jnp.sum(lq[1] * lk[1])) + lam_init
    kpos = jnp.arange(seq)
    scale = A_QK ** -0.5

    def block(args):
        q_blk, i = args
        qpos = i * BLOCK + jnp.arange(BLOCK)
        dist = qpos[:, None] - kpos[None, :]
        bias = jnp.moveaxis(rel_bias(rel_table, dist, A_BIAS0, A_HEADS), -1, 0)
        s = jnp.einsum('bqhmd,bkhmd->bhmqk', q_blk, k).astype(jnp.float32) * scale + bias[None, :, None]
        s = jnp.where(dist >= 0, s, -jnp.inf)
        p = jax.nn.softmax(s, axis=-1)
        w = p[:, :, 0] - lam * p[:, :, 1]
        return jnp.einsum('bhqk,bkhe->bqhe', w.astype(v.dtype), v)

    o = lax.map(block, (qb, jnp.arange(nb)))
    o = jnp.moveaxis(o, 0, 1).reshape(bsz, seq, A_HEADS, A_V)
    o = rms_norm(o, subln_g) * (1.0 - lam_init)
    return o.reshape(bsz, seq, A_HEADS * A_V)


def sliding_sink_attention(q, k, v, sinks, rel_table):
    bsz, seq, _ = q.shape
    nb = seq // BLOCK
    rep = B_QHEADS // B_KVHEADS
    q = q.reshape(bsz, nb, BLOCK, B_KVHEADS, rep, HEAD_DIM)

    def band(a):
        a = a.reshape(bsz, nb, BLOCK, B_KVHEADS, HEAD_DIM)
        prev = jnp.pad(a[:, :-1], ((0, 0), (1, 0), (0, 0), (0, 0), (0, 0)))
        return jnp.concatenate([prev, a], axis=2)

    kb, vb = band(k), band(v)
    ql = jnp.arange(BLOCK)
    kl = jnp.arange(2 * BLOCK)
    dist = ql[:, None] + BLOCK - kl[None, :]
    bias = rel_bias(rel_table, dist, B_BIAS0, B_QHEADS).reshape(BLOCK, 2 * BLOCK, B_KVHEADS, rep)
    bias = jnp.transpose(bias, (2, 3, 0, 1))
    kpos = jnp.arange(nb)[:, None] * BLOCK - BLOCK + kl[None, :]
    valid = ((dist >= 0) & (dist < B_WINDOW))[None] & (kpos >= 0)[:, None, :]
    s = jnp.einsum('bnqgrd,bnkgd->bngrqk', q, kb).astype(jnp.float32) * HEAD_DIM ** -0.5 + bias[None, None]
    s = jnp.where(valid[None, :, None, None], s, -jnp.inf)
    sink = jnp.broadcast_to(
        sinks.astype(jnp.float32).reshape(B_KVHEADS, rep)[None, None, :, :, None, None], s.shape[:-1] + (1,))
    p = jax.nn.softmax(jnp.concatenate([s, sink], axis=-1), axis=-1)[..., :-1]
    o = jnp.einsum('bngrqk,bnkgd->bnqgrd', p.astype(vb.dtype), vb)
    return o.reshape(bsz, seq, B_QHEADS * HEAD_DIM)


def dilated_attention(q, k, v, rel_table):
    bsz, seq, _ = q.shape
    nb = seq // BLOCK
    n_pat = len(C_PATTERNS)
    q = q.reshape(bsz, seq, n_pat, C_HEADS, HEAD_DIM)
    k = k.reshape(bsz, seq, n_pat, C_HEADS, HEAD_DIM)
    v = v.reshape(bsz, seq, n_pat, C_HEADS, HEAD_DIM)
    k_groups = [k[:, :, g] for g in range(n_pat)]
    v_groups = [v[:, :, g] for g in range(n_pat)]
    scale = HEAD_DIM ** -0.5

    def block(i):
        qpos = i * BLOCK + jnp.arange(BLOCK)
        q_blk = lax.dynamic_slice_in_dim(q, i * BLOCK, BLOCK, axis=1)
        outs, lses = [], []
        for g, (window, dil) in enumerate(C_PATTERNS):
            dist = dil * jnp.arange(window // dil + 1)
            idx = qpos[:, None] - dist[None, :]
            valid = idx >= 0
            idx = jnp.maximum(idx, 0)
            kg = k_groups[g][:, idx]
            vg = v_groups[g][:, idx]
            bias = rel_bias(rel_table, dist, C_BIAS0 + g * C_HEADS, C_HEADS).T
            s = jnp.einsum('bqhd,bqjhd->bqhj', q_blk[:, :, g], kg).astype(jnp.float32) * scale + bias
            s = jnp.where(valid[None, :, None, :], s, -jnp.inf)
            m = jnp.max(s, axis=-1, keepdims=True)
            e = jnp.exp(s - m)
            den = jnp.sum(e, axis=-1)
            outs.append(jnp.einsum('bqhj,bqjhd->bqhd', e, vg.astype(jnp.float32)) / den[..., None])
            lses.append(m[..., 0] + jnp.log(den))
        alpha = jax.nn.softmax(jnp.stack(lses, 0), axis=0)
        return jnp.sum(alpha[..., None] * jnp.stack(outs, 0), axis=0)

    o = lax.map(block, jnp.arange(nb))
    return jnp.moveaxis(o, 0, 1).reshape(bsz, seq, C_HEADS * HEAD_DIM).astype(v.dtype)


def indexed_sparse_attention(q, k, v, iq, ik, iw, rel_table):
    bsz, seq, _ = q.shape
    nb = seq // BLOCK
    k_sel = min(D_TOPK_MAX, seq // 4)
    q = q.reshape(bsz, seq, D_HEADS, HEAD_DIM)
    iq = iq.reshape(bsz, seq, IDX_HEADS, IDX_DIM)
    kpos = jnp.arange(seq)
    gather = jax.vmap(lambda a, idx: a[idx])
    scale = HEAD_DIM ** -0.5

    def block(i):
        qpos = i * BLOCK + jnp.arange(BLOCK)
        q_blk = lax.dynamic_slice_in_dim(q, i * BLOCK, BLOCK, axis=1)
        iq_blk = lax.dynamic_slice_in_dim(iq, i * BLOCK, BLOCK, axis=1)
        iw_blk = lax.dynamic_slice_in_dim(iw, i * BLOCK, BLOCK, axis=1)
        rel = jax.nn.relu(jnp.einsum('bqhd,bsd->bqhs', iq_blk, ik).astype(jnp.float32))
        index_score = jnp.einsum('bqhs,bqh->bqs', rel, iw_blk.astype(jnp.float32))
        index_score = jnp.where(kpos[None, None, :] <= qpos[None, :, None], index_score, -jnp.inf)
        _, sel = lax.top_k(index_score, k_sel)
        dist = qpos[None, :, None] - sel
        kg = gather(k, sel)
        vg = gather(v, sel)
        bias = jnp.moveaxis(rel_bias(rel_table, dist, D_BIAS0, D_HEADS), -1, 2)
        s = jnp.einsum('bqhd,bqkd->bqhk', q_blk, kg).astype(jnp.float32) * scale + bias
        s = jnp.where((dist >= 0)[:, :, None, :], s, -jnp.inf)
        p = jax.nn.softmax(s, axis=-1)
        return jnp.einsum('bqhk,bqkd->bqhd', p.astype(vg.dtype), vg)

    o = lax.map(block, jnp.arange(nb))
    return jnp.moveaxis(o, 0, 1).reshape(bsz, seq, D_HEADS * HEAD_DIM)


def hybrid_mixer(u, w_in, lam_q, lam_k, subln_g, sinks, w_branch, w_out, rel_table, layer_idx):
    bsz, seq, dm = u.shape
    parts = split_in(u @ w_in)
    o_a = diff_attention(parts['a_q'], parts['a_k'], parts['a_v'], lam_q, lam_k, subln_g, rel_table, layer_idx)
    o_b = sliding_sink_attention(parts['b_q'], parts['b_k'], parts['b_v'], sinks, rel_table)
    o_c = dilated_attention(parts['c_q'], parts['c_k'], parts['c_v'], rel_table)
    o_d = indexed_sparse_attention(parts['d_q'], parts['d_k'], parts['d_v'],
                                   parts['i_q'], parts['i_k'], parts['i_w'], rel_table)
    gates = jax.nn.sigmoid(parts['gate'].astype(jnp.float32)).reshape(bsz, seq, N_BRANCH, dm)
    branches = (o_a, o_b, o_c, o_d)
    merged = gates[:, :, 0] * (o_a @ w_branch[0])
    for i in range(1, N_BRANCH):
        merged = merged + gates[:, :, i] * (branches[i] @ w_branch[i])
    return (merged.astype(u.dtype) @ w_out).astype(u.dtype)


def routed_moe(v, w_router, b_router, w_exp_gate, w_exp_up, w_exp_down):
    bsz, seq, dm = v.shape
    n_tok = bsz * seq
    vf = v.reshape(n_tok, dm)
    probs = jax.nn.softmax((vf @ w_router).astype(jnp.float32), axis=-1)
    sel_score = probs + b_router.astype(jnp.float32)
    grp_score = jnp.sum(lax.top_k(sel_score.reshape(n_tok, N_GROUPS, EXPERTS_PER_GROUP), GROUP_SCORE_TOPK)[0], axis=-1)
    top_group = jnp.argmax(grp_score, axis=-1)
    in_group = (jnp.arange(N_EXPERTS) // EXPERTS_PER_GROUP)[None, :] == top_group[:, None]
    _, top_idx = lax.top_k(jnp.where(in_group, sel_score, -jnp.inf), TOP_K)
    top_w = jnp.take_along_axis(probs, top_idx, axis=-1)
    top_w = top_w / jnp.sum(top_w, axis=-1, keepdims=True)
    n_asg = n_tok * TOP_K
    e_a = top_idx.reshape(n_asg).astype(jnp.int32)
    tok_a = jnp.arange(n_asg, dtype=jnp.int32) // TOP_K
    w_a = top_w.reshape(n_asg)
    order = jnp.argsort(e_a)
    e_s, tok_s, w_s = e_a[order], tok_a[order], w_a[order]
    counts = jnp.zeros((N_EXPERTS,), jnp.int32).at[e_a].add(1)
    padded = (counts + MOE_BLOCK - 1) // MOE_BLOCK * MOE_BLOCK
    pad_end = jnp.cumsum(padded)
    pad_start = pad_end - padded
    start = jnp.cumsum(counts) - counts
    dest = pad_start[e_s] + jnp.arange(n_asg, dtype=jnp.int32) - start[e_s]
    n_blocks = -(-n_asg // MOE_BLOCK) + N_EXPERTS
    n_slots = n_blocks * MOE_BLOCK
    slot_tok = jnp.full((n_slots,), n_tok, jnp.int32).at[dest].set(tok_s)
    slot_w = jnp.zeros((n_slots,), jnp.float32).at[dest].set(w_s)
    block_e = jnp.minimum(jnp.searchsorted(pad_end, jnp.arange(n_blocks) * MOE_BLOCK, side='right'), N_EXPERTS - 1)
    vpad = jnp.concatenate([vf, jnp.zeros((1, dm), vf.dtype)], axis=0)
    xb = vpad[slot_tok].reshape(n_blocks, MOE_BLOCK, dm)

    def expert_block(args):
        x_blk, e = args
        h = jax.nn.silu(x_blk @ w_exp_gate[e]) * (x_blk @ w_exp_up[e])
        return h @ w_exp_down[e]

    yb = lax.map(expert_block, (xb, block_e)).reshape(n_slots, dm)
    y = jnp.zeros((n_tok + 1, dm), jnp.float32).at[slot_tok].add(yb.astype(jnp.float32) * slot_w[:, None])
    return y[:n_tok].reshape(bsz, seq, dm).astype(v.dtype)


def setup_inputs(seed: int = 0) -> dict:
    key = jax.random.key(seed)
    ks = jax.random.split(key, 21)
    L, D, E, F = DEPTH, D_MODEL, N_EXPERTS, D_FF_EXPERT

    def nrm(k, shape, s):
        return jax.random.normal(k, shape, jnp.float32) * s

    return {
        'x': nrm(ks[0], (BATCH, SEQ, D), 1.0),
        'c': nrm(ks[1], (BATCH, D), 1.0),
        'rel_table': nrm(ks[2], (REL_BUCKETS, N_BIAS_HEADS), 0.5),
        'w_router': nrm(ks[3], (D, E), D ** -0.5),
        'b_router': nrm(ks[4], (E,), 0.01),
        'w_ada': nrm(ks[5], (L, D, 6 * D), 0.1 * D ** -0.5),
        'b_ada': nrm(ks[6], (L, 6 * D), 0.01),
        'w_in': nrm(ks[7], (L, D, IN_WIDTH), D ** -0.5),
        'a_lambda_q': nrm(ks[8], (L, 2, A_QK), 0.1),
        'a_lambda_k': nrm(ks[9], (L, 2, A_QK), 0.1),
        'a_subln_g': 1.0 + nrm(ks[10], (L, A_V), 0.01),
        'b_sinks': nrm(ks[11], (L, B_QHEADS), 0.5),
        'w_branch': nrm(ks[12], (L, N_BRANCH, BRANCH_WIDTH, D), BRANCH_WIDTH ** -0.5),
        'w_out': nrm(ks[13], (L, D, D), DEEPNORM_BETA * D ** -0.5),
        'ln1_g': 1.0 + nrm(ks[14], (L, D), 0.01),
        'ln1_b': nrm(ks[15], (L, D), 0.01),
        'w_exp_gate': nrm(ks[16], (L, E, D, F), D ** -0.5),
        'w_exp_up': nrm(ks[17], (L, E, D, F), D ** -0.5),
        'w_exp_down': nrm(ks[18], (L, E, F, D), DEEPNORM_BETA * F ** -0.5),
        'ln2_g': 1.0 + nrm(ks[19], (L, D), 0.01),
        'ln2_b': nrm(ks[20], (L, D), 0.01),
    }


def reference(x, c, rel_table, w_router, b_router, w_ada, b_ada, w_in, a_lambda_q, a_lambda_k,
              a_subln_g, b_sinks, w_branch, w_out, ln1_g, ln1_b, w_exp_gate, w_exp_up, w_exp_down,
              ln2_g, ln2_b):
    cond = jax.nn.silu(c)
    for l in range(DEPTH):
        mod = (cond @ w_ada[l] + b_ada[l])[:, None, :]
        shift_a, scale_a, gate_a, shift_f, scale_f, gate_f = jnp.split(mod, 6, axis=-1)
        u = x * (1.0 + scale_a) + shift_a
        y = hybrid_mixer(u, w_in[l], a_lambda_q[l], a_lambda_k[l], a_subln_g[l], b_sinks[l],
                         w_branch[l], w_out[l], rel_table, l)
        x = layer_norm(DEEPNORM_ALPHA * x + (1.0 + gate_a) * y, ln1_g[l], ln1_b[l])
        v = x * (1.0 + scale_f) + shift_f
        y = routed_moe(v, w_router, b_router, w_exp_gate[l], w_exp_up[l], w_exp_down[l])
        x = layer_norm(DEEPNORM_ALPHA * x + (1.0 + gate_f) * y, ln2_g[l], ln2_b[l])
    return x
```

```cpp
#include <hip/hip_runtime.h>
#include <cstdio>
#include <cstdint>

#ifndef DBG
#define DBG 0
#endif

#define LAS __attribute__((address_space(3)))
#define GAS __attribute__((address_space(1)))
typedef unsigned short bf16_t;
typedef short bf16x8 __attribute__((ext_vector_type(8)));
typedef short s16x4 __attribute__((ext_vector_type(4)));
typedef float f32x2 __attribute__((ext_vector_type(2)));
typedef float f32x4 __attribute__((ext_vector_type(4)));
typedef float f32x16 __attribute__((ext_vector_type(16)));
typedef unsigned u32x2 __attribute__((ext_vector_type(2)));
typedef unsigned u32x4 __attribute__((ext_vector_type(4)));
typedef GAS unsigned gu32;

constexpr int D = 1024, NBATCH = 4, SEQ = 8192, M = NBATCH * SEQ, DEPTH = 2;
constexpr int INW = 8360;
constexpr int NPT = 17, NGT = 16;
constexpr int NWIN = (NPT + NGT) * 256;
constexpr int NEXP = 16, FFE = 256;
constexpr float LOG2E = 1.4426950408889634f;
constexpr int NBH = 24;
constexpr float ALPHA = 1.4142135623730951f;
constexpr float LN_EPS = 1e-5f;
constexpr float SC32 = 0.17677669529663687f * LOG2E;
constexpr float SC64 = 0.125f * LOG2E;
constexpr size_t TILE_E = (size_t)M * 256;
enum { T_AQ = 0, T_AK = 1, T_AV = 2, T_BQ = 3, T_BKV = 4, T_CQ = 5, T_CK = 8, T_CV = 11, T_DQ = 14, T_MISC = 15, T_IQ = 16 };

constexpr size_t MiB = 1u << 20;
constexpr size_t WS_CTL = 0, CTL_ZERO_BYTES = 1 * MiB;
constexpr size_t WS_MOD = 1 * MiB;
constexpr size_t WS_LAM = WS_MOD + 256 * 1024;
constexpr size_t WS_LSE = 2 * MiB;
constexpr size_t WS_LISTE = 4 * MiB;
constexpr size_t WS_LISTW = 6 * MiB;
constexpr size_t WS_WIN = 8 * MiB;
constexpr size_t WS_WB = 41 * MiB;
constexpr size_t WS_WO = 45 * MiB;
constexpr size_t WS_W1 = 49 * MiB;
constexpr size_t WS_W2 = 81 * MiB;
constexpr size_t WS_UBUF = 98 * MiB;
constexpr size_t WS_OBUF = 162 * MiB;
constexpr size_t WS_R1 = 226 * MiB;
constexpr size_t WS_IKC = 498 * MiB;
constexpr size_t WS_END = 500 * MiB;
constexpr size_t R1_H = 0, R1_Y0 = 48 * MiB, R1_Y1 = 112 * MiB;
constexpr int CW_TMO = 0, CW_CODE = 1;
constexpr int CW_BAR = 4096;
constexpr int CW_QATT = 8192;
constexpr int CW_ECNT = 9216;
constexpr int CW_ERR = 16384;

constexpr int LDS_BIG = 0, LDS_BIG_BYTES = 131072;
constexpr int LDS_AUX = 131328;
constexpr int LDS_MISC = 155904;
constexpr int LDS_BYTES = 160000;
constexpr int MISC_BARW = 0;

#define RLX_AGENT __ATOMIC_RELAXED, __HIP_MEMORY_SCOPE_AGENT
#define LDS_WAIT() asm volatile("s_waitcnt lgkmcnt(0)" ::: "memory")
#define VM_WAIT() asm volatile("s_waitcnt vmcnt(0)" ::: "memory")
typedef __bf16 bf16x2_t __attribute__((ext_vector_type(2)));
__device__ __forceinline__ unsigned cvt_pk_bf16(float lo, float hi) { f32x2 v = {lo, hi}; bf16x2_t b = __builtin_convertvector(v, bf16x2_t); return __builtin_bit_cast(unsigned, b); }
__device__ __forceinline__ float bf2f(unsigned short b) { return __uint_as_float((unsigned)b << 16); }
__device__ __forceinline__ float bflo(unsigned w) { return __uint_as_float(w << 16); }
__device__ __forceinline__ float bfhi(unsigned w) { return __uint_as_float(w & 0xffff0000u); }
__device__ __forceinline__ unsigned short f2bf(float f) { unsigned u = __float_as_uint(f); return (unsigned short)((u + 0x7fffu + ((u >> 16) & 1u)) >> 16); }
__device__ __forceinline__ int launder(int x) { asm volatile("" : "+v"(x)); return x; }
__device__ __forceinline__ int launder_si(int x) { asm volatile("" : "+s"(x)); return x; }
template <class T> __device__ __forceinline__ T* launder_s(T* p) { asm volatile("" : "+s"(p)); return p; }
__device__ __forceinline__ int lane_now() { int x; asm volatile("v_mbcnt_lo_u32_b32 %0, -1, 0\n\tv_mbcnt_hi_u32_b32 %0, -1, %0" : "=v"(x)); return x; }
template <int X> __device__ __forceinline__ float swz_xor(float v) {
    const int x = __float_as_int(v);
    if (X == 1) return __int_as_float(__builtin_amdgcn_update_dpp(0, x, 0xB1, 0xf, 0xf, false));
    if (X == 2) return __int_as_float(__builtin_amdgcn_update_dpp(0, x, 0x4E, 0xf, 0xf, false));
    if (X == 4) { int r = __builtin_amdgcn_update_dpp(0, x, 0x104, 0xf, 0x5, false);
                  r = __builtin_amdgcn_update_dpp(r, x, 0x114, 0xf, 0xa, false); return __int_as_float(r); }
    if (X == 8) return __int_as_float(__builtin_amdgcn_update_dpp(0, x, 0x128, 0xf, 0xf, false));
    return __int_as_float(__builtin_amdgcn_ds_swizzle(x, (X << 10) | 0x1f));
}
__device__ __forceinline__ unsigned wave_incl_scan(unsigned x) {
    x += (unsigned)__builtin_amdgcn_update_dpp(0, (int)x, 0x111, 0xf, 0xf, false);
    x += (unsigned)__builtin_amdgcn_update_dpp(0, (int)x, 0x112, 0xf, 0xf, false);
    x += (unsigned)__builtin_amdgcn_update_dpp(0, (int)x, 0x114, 0xf, 0xf, false);
    x += (unsigned)__builtin_amdgcn_update_dpp(0, (int)x, 0x118, 0xf, 0xf, false);
    x += (unsigned)__builtin_amdgcn_update_dpp(0, (int)x, 0x142, 0xa, 0xf, false);
    x += (unsigned)__builtin_amdgcn_update_dpp(0, (int)x, 0x143, 0xc, 0xf, false);
    return x;
}
__device__ __forceinline__ float wave_sum(float v) {
    v += swz_xor<1>(v); v += swz_xor<2>(v); v += swz_xor<4>(v); v += swz_xor<8>(v); v += swz_xor<16>(v);
    auto rr = __builtin_amdgcn_permlane32_swap(__float_as_uint(v), __float_as_uint(v), false, false);
    return __uint_as_float(rr[0]) + __uint_as_float(rr[1]);
}
__device__ __forceinline__ float fast_exp2(float x) { return __builtin_amdgcn_exp2f(x); }
__device__ __forceinline__ float fast_rcp(float x) { return __builtin_amdgcn_rcpf(x); }
__device__ __forceinline__ float sigmoidf_(float x) { return fast_rcp(1.0f + fast_exp2(-x * LOG2E)); }
__device__ __forceinline__ int t5_bucket(int n) {
    if (n < 16) return n;
    const float lr = logf((float)n / 16.0f) / 4.852030263919617f;
    int large = 16 + (int)(lr * 16.0f);
    return large < 31 ? large : 31;
}

struct Args { const float* in[21]; float* out; unsigned char* ws; int ph_lo, ph_hi; };
enum { IN_X = 0, IN_C, IN_REL, IN_WROUTER, IN_BROUTER, IN_WADA, IN_BADA, IN_WIN, IN_LAMQ, IN_LAMK, IN_SUBLN, IN_SINKS, IN_WBRANCH, IN_WOUT, IN_LN1G, IN_LN1B, IN_WEG, IN_WEU, IN_WED, IN_LN2G, IN_LN2B };
constexpr int NWAVES = 8, NTHREADS = 512;
struct Frame {
    LAS unsigned char* lds; int wave, G, vcu; gu32* ctl; unsigned char* ws;
    __device__ __forceinline__ int lane_() const { return lane_now(); }
    __device__ __forceinline__ int tid_() const { return wave * 64 + lane_now(); }
};

#define XB_TMO      128
#define XB_XCNT(j)  (256  + 64 * (j))
#define XB_XSUB(j)  (1280 + 64 * (j))
#define XB_XGEN(j)  (2304 + 64 * (j))
#define XB_TOP      3328
#define XB_TOPGEN   3392
#define XCD_BAR_WORDS 3456
#define XB_SPIN_CAP (1u << 18)
__device__ __forceinline__ unsigned xb_ld(unsigned* p)              { return __hip_atomic_load(p, __ATOMIC_RELAXED, __HIP_MEMORY_SCOPE_AGENT); }
__device__ __forceinline__ unsigned xb_add(unsigned* p, unsigned v) { return __hip_atomic_fetch_add(p, v, __ATOMIC_RELAXED, __HIP_MEMORY_SCOPE_AGENT); }
__device__ __forceinline__ unsigned xb_xcc_id() { return (unsigned)__builtin_amdgcn_s_getreg((3 << 11) | 20) & 0xFu; }
#define XB_SPIN(cond, bar) do { unsigned _sp = 0; while (cond) { __builtin_amdgcn_s_sleep(1); \
    if ((++_sp & 255u) == 0u) { if (xb_ld(&(bar)[XB_TMO])) break; if (_sp > XB_SPIN_CAP) { atomicAdd(&(bar)[XB_TMO], 1u); break; } } } } while (0)
struct XcdBarrier { unsigned* bar; unsigned x; volatile LAS unsigned* st; };
__device__ __forceinline__ XcdBarrier xcd_barrier_post(unsigned* bar, volatile LAS unsigned* st) {
    XcdBarrier b; b.bar = bar; b.x = xb_xcc_id(); b.st = st;
    if (threadIdx.x == 0) (void)xb_add(&bar[XB_XCNT(b.x)], 1u);
    return b;
}
__device__ __forceinline__ void xcd_barrier_complete(unsigned* bar, unsigned x, unsigned& nloc, unsigned& nx) {
    const unsigned G = gridDim.x * gridDim.y * gridDim.z;
    unsigned sum, cnt, mine, sp = 0u;
    for (;;) {
        sum = 0u; cnt = 0u; mine = 0u;
#pragma unroll
        for (unsigned j = 0; j < 16; ++j) { const unsigned c = xb_ld(&bar[XB_XCNT(j)]); sum += c; cnt += (c > 0u) ? 1u : 0u; mine = (j == x) ? c : mine; }
        if (sum == G) break;
        __builtin_amdgcn_s_sleep(1);
        if ((++sp & 255u) == 0u) { if (xb_ld(&bar[XB_TMO])) break; if (sp > XB_SPIN_CAP) { atomicAdd(&bar[XB_TMO], 1u); break; } }
    }
    nloc = mine > 0u ? mine : 1u; nx = cnt > 0u ? cnt : 1u;
}
__device__ __forceinline__ void xcd_barrier(const XcdBarrier& b) {
    asm volatile("s_waitcnt vmcnt(0)" ::: "memory");
    __syncthreads();
    if (threadIdx.x == 0) {
        unsigned* bar = b.bar;
        __builtin_amdgcn_s_waitcnt(0);
        unsigned nloc = b.st[0], nx = b.st[1];
        if (nloc == 0u) { xcd_barrier_complete(bar, b.x, nloc, nx); b.st[0] = nloc; b.st[1] = nx; }
        const unsigned old = xb_add(&bar[XB_XSUB(b.x)], 1u);
        const unsigned gen = old / nloc;
        if (old + 1u == (gen + 1u) * nloc) {
            __builtin_amdgcn_fence(__ATOMIC_RELEASE, "agent");
            asm volatile("s_waitcnt vmcnt(0)" ::: "memory");
            const unsigned og = xb_add(&bar[XB_TOP], 1u);
            const unsigned tg = og / nx;
            if (og + 1u == (tg + 1u) * nx) xb_add(&bar[XB_TOPGEN], 1u);
            else XB_SPIN(xb_ld(&bar[XB_TOPGEN]) == tg, bar);
            __builtin_amdgcn_fence(__ATOMIC_ACQUIRE, "agent");
            xb_add(&bar[XB_XGEN(b.x)], 1u);
            asm volatile("s_waitcnt vmcnt(0)" ::: "memory");
        } else {
            XB_SPIN(xb_ld(&bar[XB_XGEN(b.x)]) == gen, bar);
            __builtin_amdgcn_fence(__ATOMIC_ACQUIRE, "agent");
            asm volatile("s_waitcnt vmcnt(0)" ::: "memory");
        }
    }
    __syncthreads();
}

namespace pg8 {
constexpr int BM = 256, BK = 64, HALF = 128, HTB = HALF * BK * 2, STAGE_BYTES = 8 * HTB, NXCD = 8, WGM = 8;
__host__ __device__ __forceinline__ int lds_byte(int r, int c) { const int st = (r >> 4) * 2 + (c >> 5), rr = r & 15, cc = c & 31, ob = rr * 64 + cc * 2; return st * 1024 + (ob ^ (((ob >> 9) & 1) << 5)); }
__host__ __device__ __forceinline__ void stage_rc(int b, int& R, int& C) { const int st = b / 1024, sb = b % 1024, swz = sb ^ (((sb >> 9) & 1) << 5); R = (st >> 1) * 16 + swz / 64; C = (st & 1) * 32 + (swz % 64) / 2; }
__host__ __device__ __forceinline__ int perm32(int rho) { const int n = rho >> 4, i = rho & 15; return 8 * (i >> 2) + 4 * n + (i & 3); }
struct Unit { int pm, pn, e, rt, ce; };

struct FullOrder {
    const char* A; const char* Bt; int K, lda; int nM, nN, nwg, G, c;
    __device__ __forceinline__ void init(const void* A_, int lda_, const void* Bt_, int K_, int M_, int N_, int G_, int c_) { A = (const char*)A_; Bt = (const char*)Bt_; K = K_; lda = lda_; nM = M_ / BM; nN = N_ / BM; nwg = nM * nN; G = G_; c = c_; }
    __device__ __forceinline__ bool next(int i, Unit& u) const {
        const long L = (long)i * G + c; if (L >= nwg) return false;
        int wgid = (int)L; { const int q = nwg / NXCD, r = nwg % NXCD, xcd = wgid % NXCD, off = wgid / NXCD; wgid = (xcd < r ? xcd * (q + 1) : r * (q + 1) + (xcd - r) * q) + off; }
        const int nig = WGM * nN, gid = wgid / nig, fm = gid * WGM, gsz = (nM - fm) < WGM ? (nM - fm) : WGM;
        u.pm = fm + ((wgid % nig) % gsz); u.pn = (wgid % nig) / gsz; u.e = 0; u.rt = 0; u.ce = 0; return true;
    }
    __device__ __forceinline__ const char* ptrA(const Unit& u) const { return A + (size_t)u.pm * BM * lda * 2; }
    __device__ __forceinline__ const char* ptrB(const Unit& u) const { return Bt + (size_t)u.pn * BM * K * 2; }
    __device__ __forceinline__ unsigned rowoffA(const Unit&, int) const { return 0u; }
    __device__ __forceinline__ unsigned rowrawA(const Unit&, int) const { return 0u; }
    __device__ __forceinline__ unsigned rowcvtA(unsigned) const { return 0u; }
};

#define PG8_SA(b, h) (((b) * 2 + (h)) * HTB)
#define PG8_SB(b, h) ((4 + (b) * 2 + (h)) * HTB)
#define PG8_WAIT_V(n) asm volatile("s_waitcnt vmcnt(" #n ")" ::: "memory")
#define PG8_WAIT_L(n) asm volatile("s_waitcnt lgkmcnt(" #n ")" ::: "memory")
#define PG8_BAR __builtin_amdgcn_s_barrier()
#define PG8_SCHED __builtin_amdgcn_sched_barrier(0)

template <class Epi, class Sched, bool ALIGN_EPI, bool GATHER>
__device__ __forceinline__ void gemm_phase(LAS unsigned char* lds, const Sched& S, const Epi& E, int wave_) {
    const int wid = __builtin_amdgcn_readfirstlane(wave_), lane = lane_now(), tid = wid * 64 + lane, wr = wid >> 2, wc = wid & 3, fr = lane & 15, fq = lane >> 4;
    const int K = S.K, nt = K / BK, lda = S.lda;
    unsigned voffA[2], voffB[2]; int RA[2], CA[2];
#pragma unroll
    for (int i = 0; i < 2; ++i) { int R, C; stage_rc(tid * 16 + i * 8192, R, C); const int Rb = (R & ~31) + perm32(R & 31);
        voffA[i] = (unsigned)(R * lda + C) * 2u; voffB[i] = (unsigned)(Rb * K + C) * 2u; RA[i] = R; CA[i] = C; }
    const size_t kstep = (size_t)(BK * 2);
    const size_t hstepA = (size_t)HALF * lda * 2, hstepB = (size_t)HALF * K * 2;
    const unsigned ldsw = (unsigned)wid * 1024u;
    const int aoff = lds_byte(wr * 64 + fr, fq * 8), boff = lds_byte(wc * 32 + fr, fq * 8);
    unsigned vAc[2][2], vAn[2][2];
#define PG8_STG(bufoff, gptr, v0, v1) do { \
        __builtin_amdgcn_global_load_lds((const unsigned*)((const char*)(gptr) + (v0)), (LAS unsigned*)(lds + (bufoff) + ldsw), 16, 0, 0); \
        __builtin_amdgcn_global_load_lds((const unsigned*)((const char*)(gptr) + (v1)), (LAS unsigned*)(lds + (bufoff) + ldsw + 8192), 16, 0, 0); } while (0)
#define PG8_STB(b, h, ptr) PG8_STG(PG8_SB(b, h), (ptr) + (h) * hstepB, voffB[0], voffB[1])
#define PG8_STA(b, h, ptr, nx) do { if constexpr (GATHER) { const unsigned v0_ = (nx) ? vAn[h][0] : vAc[h][0], v1_ = (nx) ? vAn[h][1] : vAc[h][1]; PG8_STG(PG8_SA(b, h), (ptr), v0_, v1_); } \
        else { PG8_STG(PG8_SA(b, h), (ptr) + (h) * hstepA, voffA[0], voffA[1]); } } while (0)
#define PG8_LDA(dst, b, h) do { _Pragma("unroll") for (int m = 0; m < 4; ++m) _Pragma("unroll") for (int k = 0; k < 2; ++k) dst[m][k] = *(const LAS bf16x8*)(lds + PG8_SA(b, h) + aoff + m * 2048 + k * 1024); } while (0)
#define PG8_LDB(dst, b, h) do { _Pragma("unroll") for (int n = 0; n < 2; ++n) _Pragma("unroll") for (int k = 0; k < 2; ++k) dst[n][k] = *(const LAS bf16x8*)(lds + PG8_SB(b, h) + boff + n * 2048 + k * 1024); } while (0)
#define PG8_MMA(ai, bj, At, Bt) do { __builtin_amdgcn_s_setprio(1); _Pragma("unroll") for (int m = 0; m < 4; ++m) _Pragma("unroll") for (int n = 0; n < 2; ++n) _Pragma("unroll") for (int k = 0; k < 2; ++k) \
        acc[ai][bj][m][n] = __builtin_amdgcn_mfma_f32_16x16x32_bf16(Bt[n][k], At[m][k], acc[ai][bj][m][n], 0, 0, 0); __builtin_amdgcn_s_setprio(0); } while (0)
    Unit cur, nxt; int ui = 0;
    if (!S.next(0, cur)) return;
    f32x4 acc[2][2][4][2];
#pragma unroll
    for (int a = 0; a < 2; ++a)
#pragma unroll
        for (int b = 0; b < 2; ++b)
#pragma unroll
            for (int m = 0; m < 4; ++m)
#pragma unroll
                for (int n = 0; n < 2; ++n) acc[a][b][m][n] = (f32x4){0.f, 0.f, 0.f, 0.f};
    bf16x8 At[4][2], B0[2][2], B1[2][2];
    const char* cA = S.ptrA(cur); const char* cB = S.ptrB(cur);
    if constexpr (GATHER) {
#pragma unroll
        for (int h = 0; h < 2; ++h)
#pragma unroll
            for (int i = 0; i < 2; ++i) { vAc[h][i] = S.rowoffA(cur, h * HALF + RA[i]) + (unsigned)CA[i] * 2u; vAn[h][i] = vAc[h][i]; }
        __builtin_amdgcn_sched_barrier(0);
    }
    PG8_STB(0, 0, cB); PG8_STB(0, 1, cB); PG8_STA(0, 0, cA, false); PG8_STA(0, 1, cA, false);
    if (wr == 1) PG8_BAR;
    PG8_WAIT_V(2); PG8_BAR;
    PG8_STB(1, 0, cB + kstep); PG8_STA(1, 0, cA + kstep, false); PG8_STB(1, 1, cB + kstep);
    PG8_WAIT_V(6); PG8_BAR;
    for (;;) {
        const bool has_next = S.next(ui + 1, nxt);
        const char* nA = has_next ? S.ptrA(nxt) : cA; const char* nB = has_next ? S.ptrB(nxt) : cB;
        if constexpr (GATHER) {
            if (has_next) {
#pragma unroll
                for (int h = 0; h < 2; ++h)
#pragma unroll
                    for (int i = 0; i < 2; ++i) vAn[h][i] = S.rowrawA(nxt, h * HALF + RA[i]);
                __builtin_amdgcn_sched_barrier(0);
#pragma unroll
                for (int h = 0; h < 2; ++h)
#pragma unroll
                    for (int i = 0; i < 2; ++i) vAn[h][i] = S.rowcvtA(vAn[h][i]) + (unsigned)CA[i] * 2u;
            }
        }
        for (int t = 0; t < nt; t += 2) {
            const bool last = (t == nt - 2);
            const bool nx = last && has_next;
            const char* a1 = cA + (size_t)(t + 1) * kstep;
            const char* a2 = last ? nA : cA + (size_t)(t + 2) * kstep; const char* b2 = last ? nB : cB + (size_t)(t + 2) * kstep;
            const char* a3 = a2 + kstep; const char* b3 = b2 + kstep;
            PG8_LDB(B0, 0, 0); PG8_LDB(B1, 0, 1); PG8_SCHED; PG8_LDA(At, 0, 0); PG8_STA(1, 1, a1, false);
            PG8_WAIT_V(8); PG8_WAIT_L(0); PG8_BAR; PG8_MMA(0, 0, At, B0); PG8_MMA(0, 1, At, B1); PG8_BAR; PG8_SCHED;
            PG8_LDA(At, 0, 1); PG8_STB(0, 0, b2); PG8_STB(0, 1, b2); PG8_STA(0, 0, a2, nx);
            PG8_WAIT_V(8); PG8_WAIT_L(0); PG8_BAR; PG8_MMA(1, 0, At, B0); PG8_MMA(1, 1, At, B1); PG8_BAR; PG8_SCHED;
            PG8_LDB(B0, 1, 0); PG8_LDB(B1, 1, 1); PG8_SCHED; PG8_LDA(At, 1, 0); PG8_STA(0, 1, a2, nx);
            PG8_WAIT_V(8); PG8_WAIT_L(0); PG8_BAR; PG8_MMA(0, 0, At, B0); PG8_MMA(0, 1, At, B1); PG8_BAR; PG8_SCHED;
            PG8_LDA(At, 1, 1); PG8_STB(1, 0, b3); PG8_STB(1, 1, b3); PG8_STA(1, 0, a3, nx);
            PG8_WAIT_V(8); PG8_WAIT_L(0); PG8_BAR; PG8_MMA(1, 0, At, B0); PG8_MMA(1, 1, At, B1); PG8_BAR; PG8_SCHED;
        }
        if constexpr (ALIGN_EPI) { if (wr == 0) PG8_BAR; }
        E(acc, cur, wr, wc, fr, fq);
        if (!has_next) break;
#pragma unroll
        for (int a = 0; a < 2; ++a)
#pragma unroll
            for (int b = 0; b < 2; ++b)
#pragma unroll
                for (int m = 0; m < 4; ++m)
#pragma unroll
                    for (int n = 0; n < 2; ++n) acc[a][b][m][n] = (f32x4){0.f, 0.f, 0.f, 0.f};
        cur = nxt; cA = nA; cB = nB; ++ui;
        if constexpr (GATHER) {
#pragma unroll
            for (int h = 0; h < 2; ++h)
#pragma unroll
                for (int i = 0; i < 2; ++i) vAc[h][i] = vAn[h][i];
        }
        if constexpr (ALIGN_EPI) { if (wr == 1) PG8_BAR; }
    }
    PG8_WAIT_V(0);
    if constexpr (!ALIGN_EPI) { if (wr == 0) PG8_BAR; }
    PG8_BAR;
#undef PG8_STG
#undef PG8_STB
#undef PG8_STA
#undef PG8_LDA
#undef PG8_LDB
#undef PG8_MMA
}

__device__ __forceinline__ u32x4 pack8(f32x4 v0, f32x4 v1) { u32x4 w; w.x = cvt_pk_bf16(v0[0], v0[1]); w.y = cvt_pk_bf16(v0[2], v0[3]); w.z = cvt_pk_bf16(v1[0], v1[1]); w.w = cvt_pk_bf16(v1[2], v1[3]); return w; }
__device__ __forceinline__ int perm_row(int grow, int lg) {
    const int t = grow & (SEQ - 1);
    return (grow & ~(SEQ - 1)) | ((t & ((1 << lg) - 1)) << (13 - lg)) | (t >> lg);
}
struct EpiInproj {
    bf16_t* R1; bf16_t* IKC;
    __device__ __forceinline__ void operator()(const f32x4 (&acc)[2][2][4][2], const Unit& u, int wr, int wc, int fr, int fq) const {
        const int pn = u.pn;
        float sc = 1.f; if (pn == T_AQ) sc = SC32; else if (pn == T_BQ || pn == T_DQ || (pn >= T_CQ && pn < T_CQ + 3)) sc = SC64;
        int lg = 0; if (pn >= T_CQ && pn < T_CV + 3) { const int g = (pn - T_CQ) % 3; lg = 2 * g; }
        bf16_t* base = R1 + (size_t)pn * TILE_E + wc * 32 + 8 * fq;
        const int row0 = u.pm * BM + wr * 64 + fr;
#pragma unroll
        for (int ai = 0; ai < 2; ++ai)
#pragma unroll
            for (int m = 0; m < 4; ++m) { const int grow = row0 + ai * HALF + m * 16; const int prow = perm_row(grow, lg); bf16_t* rowp = base + (size_t)prow * 256;
#pragma unroll
                for (int bj = 0; bj < 2; ++bj) *(u32x4*)(rowp + bj * HALF) = pack8(acc[ai][bj][m][0] * sc, acc[ai][bj][m][1] * sc);
                if (pn == T_MISC && wc == 0) *(u32x4*)(IKC + (size_t)grow * 32 + 8 * fq) = pack8(acc[ai][1][m][0], acc[ai][1][m][1]); }
    }
};

struct EpiGate {
    bf16_t* R1;
    __device__ __forceinline__ void operator()(const f32x4 (&acc)[2][2][4][2], const Unit& u, int wr, int wc, int fr, int fq) const {
        bf16_t* base = R1 + (size_t)u.pn * TILE_E + wc * 32 + 8 * fq;
        const int row0 = u.pm * BM + wr * 64 + fr;
#pragma unroll
        for (int ai = 0; ai < 2; ++ai)
#pragma unroll
            for (int m = 0; m < 4; ++m) { bf16_t* rowp = base + (size_t)(row0 + ai * HALF + m * 16) * 256;
#pragma unroll
                for (int bj = 0; bj < 2; ++bj) { f32x4 v0 = acc[ai][bj][m][0], v1 = acc[ai][bj][m][1];
#pragma unroll
                    for (int i = 0; i < 4; ++i) { v0[i] = sigmoidf_(v0[i]); v1[i] = sigmoidf_(v1[i]); }
                    *(u32x4*)(rowp + bj * HALF) = pack8(v0, v1); } }
    }
};
struct EpiPlain {
    bf16_t* O; int ldc;
    __device__ __forceinline__ void operator()(const f32x4 (&acc)[2][2][4][2], const Unit& u, int wr, int wc, int fr, int fq) const {
        bf16_t* base = O + u.pn * BM + wc * 32 + 8 * fq;
        const int row0 = u.pm * BM + wr * 64 + fr;
#pragma unroll
        for (int ai = 0; ai < 2; ++ai)
#pragma unroll
            for (int m = 0; m < 4; ++m) { bf16_t* rowp = base + (size_t)(row0 + ai * HALF + m * 16) * ldc;
#pragma unroll
                for (int bj = 0; bj < 2; ++bj) *(u32x4*)(rowp + bj * HALF) = pack8(acc[ai][bj][m][0], acc[ai][bj][m][1]); }
    }
};
__device__ __forceinline__ void unpack8(u32x4 w, f32x4& v0, f32x4& v1) { v0 = (f32x4){bflo(w.x), bfhi(w.x), bflo(w.y), bfhi(w.y)}; v1 = (f32x4){bflo(w.z), bfhi(w.z), bflo(w.w), bfhi(w.w)}; }
struct EpiMerge {
    const bf16_t* gates; bf16_t* Mg;
    __device__ __forceinline__ void operator()(const f32x4 (&acc)[2][2][4][2], const Unit& u, int wr, int wc, int fr, int fq) const {
        const bf16_t* gb = gates + (size_t)(u.e * 4 + u.pn) * TILE_E + wc * 32 + 8 * fq;
        bf16_t* mb = Mg + u.pn * BM + wc * 32 + 8 * fq;
        const int row0 = u.pm * BM + wr * 64 + fr;
#pragma unroll
        for (int ai = 0; ai < 2; ++ai) {
            u32x4 gv[4][2], ov[4][2];
#pragma unroll
            for (int m = 0; m < 4; ++m)
#pragma unroll
                for (int bj = 0; bj < 2; ++bj) { const size_t row = (size_t)(row0 + ai * HALF + m * 16); gv[m][bj] = *(const u32x4*)(gb + row * 256 + bj * HALF);
                    ov[m][bj] = (u32x4){0u, 0u, 0u, 0u}; if (u.e > 0) ov[m][bj] = *(const u32x4*)(mb + row * 1024 + bj * HALF); }
#pragma unroll
            for (int m = 0; m < 4; ++m)
#pragma unroll
                for (int bj = 0; bj < 2; ++bj) { const size_t row = (size_t)(row0 + ai * HALF + m * 16); f32x4 g0, g1, o0, o1; unpack8(gv[m][bj], g0, g1); unpack8(ov[m][bj], o0, o1);
                    *(u32x4*)(mb + row * 1024 + bj * HALF) = pack8(acc[ai][bj][m][0] * g0 + o0, acc[ai][bj][m][1] * g1 + o1); }
        }
    }
};
struct MergeOrder {
    FullOrder fo; const char* Wb;
    __device__ __forceinline__ bool next(int i, Unit& u) const { if (!fo.next(i >> 2, u)) return false; u.e = i & 3; return true; }
    int K, lda;
    __device__ __forceinline__ const char* ptrA(const Unit& u) const { return fo.A + ((size_t)u.pm * BM * 1024 + (size_t)u.e * 256) * 2; }
    __device__ __forceinline__ const char* ptrB(const Unit& u) const { return Wb + ((size_t)u.e * 1024 + (size_t)u.pn * BM) * 256 * 2; }
    __device__ __forceinline__ unsigned rowoffA(const Unit&, int) const { return 0u; }
    __device__ __forceinline__ unsigned rowrawA(const Unit&, int) const { return 0u; }
    __device__ __forceinline__ unsigned rowcvtA(unsigned) const { return 0u; }
};
struct MoeOrder {
    int pre[17]; int cnt[16]; int ncol, G, c; const char* A; const char* W; size_t wstride; const unsigned* liste; int K, lda;
    __device__ __forceinline__ void init(const gu32* ecnt, int ncol_, int G_, int c_) { int s = 0;
#pragma unroll
        for (int e = 0; e < 16; ++e) { int ce = (int)__hip_atomic_load(ecnt + 64 * e, RLX_AGENT); ce = ce > 32768 ? 32768 : ce; cnt[e] = ce; pre[e] = s; s += (ce + 255) >> 8; }
        pre[16] = s; ncol = ncol_; G = G_; c = c_; }
    __device__ __forceinline__ bool next(int i, Unit& u) const {
        const int L = i * G + c; if (L >= pre[16] * ncol) return false;
        const int rtg = L / ncol; u.pn = L - rtg * ncol; u.pm = rtg; int e = 0;
#pragma unroll
        for (int k = 1; k < 16; ++k) e += (rtg >= pre[k]) ? 1 : 0;
        u.e = e; int pe = 0;
#pragma unroll
        for (int k = 0; k < 16; ++k) pe = (k == e) ? pre[k] : pe;
        u.rt = rtg - pe; u.ce = count(e); return true; }
    __device__ __forceinline__ int count(int e) const { int ce = 0;
#pragma unroll
        for (int k = 0; k < 16; ++k) ce = (k == e) ? cnt[k] : ce;
        return ce; }
    __device__ __forceinline__ const char* ptrA(const Unit& u) const { return lda ? A + (size_t)u.pm * BM * lda * 2 : A; }
    __device__ __forceinline__ const char* ptrB(const Unit& u) const { return W + (size_t)u.e * wstride + (size_t)u.pn * BM * K * 2; }
    __device__ __forceinline__ unsigned rowoffA(const Unit& u, int r) const {
        const int ce = u.ce; int s = u.rt * 256 + r; s = s < ce ? s : ce - 1;
        return (liste[(size_t)u.e * 32768 + s] >> 1) * 2048u; }
    __device__ __forceinline__ unsigned rowrawA(const Unit& u, int r) const { const int ce = u.ce; int s = u.rt * 256 + r; s = s < ce ? s : ce - 1; return liste[(size_t)u.e * 32768 + s]; }
    __device__ __forceinline__ unsigned rowcvtA(unsigned raw) const { return (raw >> 1) * 2048u; }
};
struct EpiMoe1 {
    bf16_t* H;
    __device__ __forceinline__ void operator()(const f32x4 (&acc)[2][2][4][2], const Unit& u, int wr, int wc, int fr, int fq) const {
        bf16_t* base = H + u.pn * 128 + wc * 32 + 8 * fq;
        const int row0 = u.pm * BM + wr * 64 + fr;
#pragma unroll
        for (int ai = 0; ai < 2; ++ai)
#pragma unroll
            for (int m = 0; m < 4; ++m) { f32x4 v0, v1;
#pragma unroll
                for (int i = 0; i < 4; ++i) { const float g0 = acc[ai][0][m][0][i], g1 = acc[ai][0][m][1][i]; v0[i] = g0 * sigmoidf_(g0) * acc[ai][1][m][0][i]; v1[i] = g1 * sigmoidf_(g1) * acc[ai][1][m][1][i]; }
                *(u32x4*)(base + (size_t)(row0 + ai * HALF + m * 16) * 256) = pack8(v0, v1); }
    }
};
struct EpiMoe2 {
    bf16_t* Y0; bf16_t* Y1; const unsigned* liste; const float* listw;
    __device__ __forceinline__ void operator()(const f32x4 (&acc)[2][2][4][2], const Unit& u, int wr, int wc, int fr, int fq) const {
        const int ce = u.ce; const int col = u.pn * BM + wc * 32 + 8 * fq;
        unsigned ent[2][4]; float wgt[2][4];
#pragma unroll
        for (int ai = 0; ai < 2; ++ai)
#pragma unroll
            for (int m = 0; m < 4; ++m) { int s = u.rt * 256 + wr * 64 + fr + ai * HALF + m * 16; s = s < ce ? s : ce - 1; ent[ai][m] = liste[(size_t)u.e * 32768 + s]; wgt[ai][m] = listw[(size_t)u.e * 32768 + s]; }
#pragma unroll
        for (int ai = 0; ai < 2; ++ai)
#pragma unroll
            for (int m = 0; m < 4; ++m) { const int s = u.rt * 256 + wr * 64 + fr + ai * HALF + m * 16;
                if (s < ce) { bf16_t* rowp = Y0 + (size_t)(ent[ai][m] & 1u) * ((R1_Y1 - R1_Y0) / 2) + (size_t)(ent[ai][m] >> 1) * 1024 + col;
#pragma unroll
                    for (int bj = 0; bj < 2; ++bj) *(u32x4*)(rowp + bj * HALF) = pack8(acc[ai][bj][m][0] * wgt[ai][m], acc[ai][bj][m][1] * wgt[ai][m]); } }
    }
};
}


namespace att {
typedef LAS const char* lds_cptr;
constexpr int NSLOT = 3, SLOTB = 8192;
constexpr int L_K = 0, L_V = NSLOT * SLOTB, L_OST = 2 * NSLOT * SLOTB  , OST_BYTES = 8704  , L_LUT = L_OST + 8 * OST_BYTES  , LUT_OFF = 96, LUT_N = 1728;
constexpr int L_WSF = LDS_AUX;
constexpr int FAR_DIST = 1513;
static_assert(L_LUT + LUT_N * 4 <= LDS_BIG_BYTES, "attention LDS map");
__device__ __forceinline__ int crow(int r, int hi) { return (r & 3) + 8 * (r >> 2) + 4 * hi; }
#define SBAR() __builtin_amdgcn_sched_barrier(0)
__device__ __forceinline__ void glds16(const void* gsrc, unsigned lds_dst) { unsigned keep;
    asm volatile("s_mov_b32 %0, m0\n\ts_mov_b32 m0, %2\n\ts_nop 0\n\tglobal_load_lds_dwordx4 %1, off\n\ts_mov_b32 m0, %0" : "=&s"(keep) : "v"(gsrc), "s"(lds_dst) : "memory"); }
template <int D0, int ND> __device__ __forceinline__ void qkt(f32x16& p0, f32x16& p1, lds_cptr kp, const bf16x8* qr, float cinit) {
    f32x16 c;
#pragma unroll
    for (int r = 0; r < 16; ++r) c[r] = cinit;
#pragma unroll
    for (int d = 0; d < ND; ++d) {
        const bf16x8 b0 = *(const LAS bf16x8*)(kp + (D0 + d) * 2048);
        const bf16x8 b1 = *(const LAS bf16x8*)(kp + (D0 + d) * 2048 + 512);
        if (d == 0) { p0 = __builtin_amdgcn_mfma_f32_32x32x16_bf16(b0, qr[D0 + d], c, 0, 0, 0); p1 = __builtin_amdgcn_mfma_f32_32x32x16_bf16(b1, qr[D0 + d], c, 0, 0, 0); }
        else { p0 = __builtin_amdgcn_mfma_f32_32x32x16_bf16(b0, qr[D0 + d], p0, 0, 0, 0); p1 = __builtin_amdgcn_mfma_f32_32x32x16_bf16(b1, qr[D0 + d], p1, 0, 0, 0); }
    }
}
__device__ __forceinline__ void load_kfrags(bf16x8 (&kf)[8], lds_cptr kp) {
#pragma unroll
    for (int d = 0; d < 4; ++d) { kf[2 * d] = *(const LAS bf16x8*)(kp + d * 2048); kf[2 * d + 1] = *(const LAS bf16x8*)(kp + d * 2048 + 512); }
    SBAR();
}
template <int D0, int ND> __device__ __forceinline__ void qkt_f(f32x16& p0, f32x16& p1, const bf16x8 (&kf)[8], const bf16x8* qr, float cinit) {
    f32x16 c;
#pragma unroll
    for (int r = 0; r < 16; ++r) c[r] = cinit;
#pragma unroll
    for (int d = 0; d < ND; ++d) {
        if (d == 0) { p0 = __builtin_amdgcn_mfma_f32_32x32x16_bf16(kf[2 * (D0 + d)], qr[D0 + d], c, 0, 0, 0); p1 = __builtin_amdgcn_mfma_f32_32x32x16_bf16(kf[2 * (D0 + d) + 1], qr[D0 + d], c, 0, 0, 0); }
        else { p0 = __builtin_amdgcn_mfma_f32_32x32x16_bf16(kf[2 * (D0 + d)], qr[D0 + d], p0, 0, 0, 0); p1 = __builtin_amdgcn_mfma_f32_32x32x16_bf16(kf[2 * (D0 + d) + 1], qr[D0 + d], p1, 0, 0, 0); }
    }
}
__device__ __forceinline__ float rowmax(const f32x16& p0, const f32x16& p1) {
    float a = fmaxf(fmaxf(p0[0], p0[1]), p1[0]), b = fmaxf(fmaxf(p0[2], p0[3]), p1[1]); a = fmaxf(fmaxf(a, p1[2]), p1[3]);
#pragma unroll
    for (int r = 4; r < 16; r += 4) { a = fmaxf(fmaxf(a, p0[r]), p0[r + 1]); b = fmaxf(fmaxf(b, p0[r + 2]), p0[r + 3]); a = fmaxf(fmaxf(a, p1[r]), p1[r + 1]); b = fmaxf(fmaxf(b, p1[r + 2]), p1[r + 3]); }
    const float m = fmaxf(a, b);
    auto rr = __builtin_amdgcn_permlane32_swap(__float_as_uint(m), __float_as_uint(m), false, false);
    return fmaxf(__uint_as_float(rr[0]), __uint_as_float(rr[1]));
}
__device__ __forceinline__ float halves_sum(float v) { auto rr = __builtin_amdgcn_permlane32_swap(__float_as_uint(v), __float_as_uint(v), false, false); return __uint_as_float(rr[0]) + __uint_as_float(rr[1]); }
__device__ __forceinline__ void pv(f32x16* o, int vb, bf16x8 pa0, bf16x8 pa1, bf16x8 pa2, bf16x8 pa3) {
#pragma unroll
    for (int d0 = 0; d0 < 2; ++d0) { s16x4 lo[4], hi[4];
#pragma unroll
        for (int ks = 0; ks < 4; ++ks) {
            asm volatile("ds_read_b64_tr_b16 %0,%1 offset:%c2" : "=&v"(lo[ks]) : "v"(vb), "i"(d0 * 4096 + ks * 1024) : "memory");
            asm volatile("ds_read_b64_tr_b16 %0,%1 offset:%c2" : "=&v"(hi[ks]) : "v"(vb), "i"(d0 * 4096 + ks * 1024 + 512) : "memory"); }
        asm volatile("s_waitcnt lgkmcnt(0)" ::: "memory"); SBAR();
#define PK(k) (bf16x8){lo[k][0], lo[k][1], lo[k][2], lo[k][3], hi[k][0], hi[k][1], hi[k][2], hi[k][3]}
        o[d0] = __builtin_amdgcn_mfma_f32_32x32x16_bf16(pa0, PK(0), o[d0], 0, 0, 0);
        o[d0] = __builtin_amdgcn_mfma_f32_32x32x16_bf16(pa1, PK(1), o[d0], 0, 0, 0);
        o[d0] = __builtin_amdgcn_mfma_f32_32x32x16_bf16(pa2, PK(2), o[d0], 0, 0, 0);
        o[d0] = __builtin_amdgcn_mfma_f32_32x32x16_bf16(pa3, PK(3), o[d0], 0, 0, 0);
#undef PK
    }
}
__device__ __forceinline__ void softmax_pv(f32x16& p0, f32x16& p1, float& m, float& l, f32x16* o, int vb, LAS float* wsf, int r32, int hi) {
    const float rm = rowmax(p0, p1);
    if (__any(rm > m + 8.0f)) {
        const float mn = fmaxf(m, rm), f = fast_exp2(m - mn); l *= f; m = mn;
        if (hi == 0) wsf[r32] = f;
        LDS_WAIT();
#pragma unroll
        for (int r = 0; r < 16; ++r) { const float fr_ = wsf[crow(r, hi)]; o[0][r] *= fr_; o[1][r] *= fr_; }
    }
    float s = 0.f;
#pragma unroll
    for (int r = 0; r < 16; ++r) { p0[r] = fast_exp2(p0[r] - m); p1[r] = fast_exp2(p1[r] - m); s += p0[r] + p1[r]; }
    l += s;
    u32x4 w0, w1, w2, w3;
    w0 = (u32x4){cvt_pk_bf16(p0[0], p0[1]), cvt_pk_bf16(p0[2], p0[3]), cvt_pk_bf16(p0[4], p0[5]), cvt_pk_bf16(p0[6], p0[7])};
    w1 = (u32x4){cvt_pk_bf16(p0[8], p0[9]), cvt_pk_bf16(p0[10], p0[11]), cvt_pk_bf16(p0[12], p0[13]), cvt_pk_bf16(p0[14], p0[15])};
    w2 = (u32x4){cvt_pk_bf16(p1[0], p1[1]), cvt_pk_bf16(p1[2], p1[3]), cvt_pk_bf16(p1[4], p1[5]), cvt_pk_bf16(p1[6], p1[7])};
    w3 = (u32x4){cvt_pk_bf16(p1[8], p1[9]), cvt_pk_bf16(p1[10], p1[11]), cvt_pk_bf16(p1[12], p1[13]), cvt_pk_bf16(p1[14], p1[15])};
    pv(o, vb, __builtin_bit_cast(bf16x8, w0), __builtin_bit_cast(bf16x8, w1), __builtin_bit_cast(bf16x8, w2), __builtin_bit_cast(bf16x8, w3));
}
__device__ __forceinline__ void softmax_pack(f32x16& p0, f32x16& p1, float& m, float& l, f32x16* o, LAS float* wsf, int r32, int hi, bf16x8 (&pa)[4]) {
    const float rm = rowmax(p0, p1);
    if (__any(rm > m + 8.0f)) {
        const float mn = fmaxf(m, rm), f = fast_exp2(m - mn); l *= f; m = mn;
        if (hi == 0) wsf[r32] = f;
        LDS_WAIT();
#pragma unroll
        for (int r = 0; r < 16; ++r) { const float fr_ = wsf[crow(r, hi)]; o[0][r] *= fr_; o[1][r] *= fr_; }
    }
    float s = 0.f;
#pragma unroll
    for (int r = 0; r < 16; ++r) { p0[r] = fast_exp2(p0[r] - m); p1[r] = fast_exp2(p1[r] - m); s += p0[r] + p1[r]; }
    l += s;
    pa[0] = __builtin_bit_cast(bf16x8, (u32x4){cvt_pk_bf16(p0[0], p0[1]), cvt_pk_bf16(p0[2], p0[3]), cvt_pk_bf16(p0[4], p0[5]), cvt_pk_bf16(p0[6], p0[7])});
    pa[1] = __builtin_bit_cast(bf16x8, (u32x4){cvt_pk_bf16(p0[8], p0[9]), cvt_pk_bf16(p0[10], p0[11]), cvt_pk_bf16(p0[12], p0[13]), cvt_pk_bf16(p0[14], p0[15])});
    pa[2] = __builtin_bit_cast(bf16x8, (u32x4){cvt_pk_bf16(p1[0], p1[1]), cvt_pk_bf16(p1[2], p1[3]), cvt_pk_bf16(p1[4], p1[5]), cvt_pk_bf16(p1[6], p1[7])});
    pa[3] = __builtin_bit_cast(bf16x8, (u32x4){cvt_pk_bf16(p1[8], p1[9]), cvt_pk_bf16(p1[10], p1[11]), cvt_pk_bf16(p1[12], p1[13]), cvt_pk_bf16(p1[14], p1[15])});
}
__device__ __forceinline__ void softmax_pack_rel(f32x16& p0, f32x16& p1, float& m, float& l, f32x16* o, LAS float* wsf, int r32, int hi, bf16x8 (&pa)[4], bool first) {
    const float rm = rowmax(p0, p1);
    if (first || __any(rm > 8.0f)) {
        const float dl = first ? fmaxf(rm, -100.f) : fmaxf(rm, 0.f), f = fast_exp2(-dl); m += dl; l *= f;
#pragma unroll
        for (int r = 0; r < 16; ++r) { p0[r] -= dl; p1[r] -= dl; }
        if (!first) {
            if (hi == 0) wsf[r32] = f;
            LDS_WAIT();
#pragma unroll
            for (int r = 0; r < 16; ++r) { const float fr_ = wsf[crow(r, hi)]; o[0][r] *= fr_; o[1][r] *= fr_; }
        }
    }
    float s = 0.f;
#pragma unroll
    for (int r = 0; r < 16; ++r) { p0[r] = fast_exp2(p0[r]); p1[r] = fast_exp2(p1[r]); s += p0[r] + p1[r]; }
    l += s;
    pa[0] = __builtin_bit_cast(bf16x8, (u32x4){cvt_pk_bf16(p0[0], p0[1]), cvt_pk_bf16(p0[2], p0[3]), cvt_pk_bf16(p0[4], p0[5]), cvt_pk_bf16(p0[6], p0[7])});
    pa[1] = __builtin_bit_cast(bf16x8, (u32x4){cvt_pk_bf16(p0[8], p0[9]), cvt_pk_bf16(p0[10], p0[11]), cvt_pk_bf16(p0[12], p0[13]), cvt_pk_bf16(p0[14], p0[15])});
    pa[2] = __builtin_bit_cast(bf16x8, (u32x4){cvt_pk_bf16(p1[0], p1[1]), cvt_pk_bf16(p1[2], p1[3]), cvt_pk_bf16(p1[4], p1[5]), cvt_pk_bf16(p1[6], p1[7])});
    pa[3] = __builtin_bit_cast(bf16x8, (u32x4){cvt_pk_bf16(p1[8], p1[9]), cvt_pk_bf16(p1[10], p1[11]), cvt_pk_bf16(p1[12], p1[13]), cvt_pk_bf16(p1[14], p1[15])});
}
__device__ __forceinline__ void pv2(f32x16* oA, f32x16* oB, int vb, const bf16x8 (&pa)[4], const bf16x8 (&pb)[4]) {
#pragma unroll
    for (int d0 = 0; d0 < 2; ++d0) { s16x4 lo[4], hi[4];
#pragma unroll
        for (int ks = 0; ks < 4; ++ks) {
            asm volatile("ds_read_b64_tr_b16 %0,%1 offset:%c2" : "=&v"(lo[ks]) : "v"(vb), "i"(d0 * 4096 + ks * 1024) : "memory");
            asm volatile("ds_read_b64_tr_b16 %0,%1 offset:%c2" : "=&v"(hi[ks]) : "v"(vb), "i"(d0 * 4096 + ks * 1024 + 512) : "memory"); }
        asm volatile("s_waitcnt lgkmcnt(0)" ::: "memory"); SBAR();
#define PK(k) (bf16x8){lo[k][0], lo[k][1], lo[k][2], lo[k][3], hi[k][0], hi[k][1], hi[k][2], hi[k][3]}
#pragma unroll
        for (int k = 0; k < 4; ++k) { const bf16x8 vf = PK(k);
            oA[d0] = __builtin_amdgcn_mfma_f32_32x32x16_bf16(pa[k], vf, oA[d0], 0, 0, 0);
            oB[d0] = __builtin_amdgcn_mfma_f32_32x32x16_bf16(pb[k], vf, oB[d0], 0, 0, 0); }
#undef PK
    }
}
__device__ __forceinline__ void first_ref(f32x16& p0, f32x16& p1, float& m) {
    const float dl = fmaxf(rowmax(p0, p1), -100.f); m = dl;
#pragma unroll
    for (int r = 0; r < 16; ++r) { p0[r] -= dl; p1[r] -= dl; }
}
__device__ __forceinline__ void exp_pack(f32x16& p0, f32x16& p1, bf16x8 (&pa)[4]) {
#pragma unroll
    for (int r = 0; r < 16; ++r) { p0[r] = fast_exp2(p0[r]); p1[r] = fast_exp2(p1[r]); }
    pa[0] = __builtin_bit_cast(bf16x8, (u32x4){cvt_pk_bf16(p0[0], p0[1]), cvt_pk_bf16(p0[2], p0[3]), cvt_pk_bf16(p0[4], p0[5]), cvt_pk_bf16(p0[6], p0[7])});
    pa[1] = __builtin_bit_cast(bf16x8, (u32x4){cvt_pk_bf16(p0[8], p0[9]), cvt_pk_bf16(p0[10], p0[11]), cvt_pk_bf16(p0[12], p0[13]), cvt_pk_bf16(p0[14], p0[15])});
    pa[2] = __builtin_bit_cast(bf16x8, (u32x4){cvt_pk_bf16(p1[0], p1[1]), cvt_pk_bf16(p1[2], p1[3]), cvt_pk_bf16(p1[4], p1[5]), cvt_pk_bf16(p1[6], p1[7])});
    pa[3] = __builtin_bit_cast(bf16x8, (u32x4){cvt_pk_bf16(p1[8], p1[9]), cvt_pk_bf16(p1[10], p1[11]), cvt_pk_bf16(p1[12], p1[13]), cvt_pk_bf16(p1[14], p1[15])});
}
__device__ __forceinline__ void pv2s(f32x16* oA, f32x16* oB, f32x4& lsA, f32x4& lsB, int vb, const bf16x8 (&pa)[4], const bf16x8 (&pb)[4]) {
    const s16x4 ones = {0x3f80, 0x3f80, 0x3f80, 0x3f80};
#pragma unroll
    for (int d0 = 0; d0 < 2; ++d0) { s16x4 lo[4], hi[4];
#pragma unroll
        for (int ks = 0; ks < 4; ++ks) {
            asm volatile("ds_read_b64_tr_b16 %0,%1 offset:%c2" : "=&v"(lo[ks]) : "v"(vb), "i"(d0 * 4096 + ks * 1024) : "memory");
            asm volatile("ds_read_b64_tr_b16 %0,%1 offset:%c2" : "=&v"(hi[ks]) : "v"(vb), "i"(d0 * 4096 + ks * 1024 + 512) : "memory"); }
        asm volatile("s_waitcnt lgkmcnt(0)" ::: "memory"); SBAR();
#define PK(k) (bf16x8){lo[k][0], lo[k][1], lo[k][2], lo[k][3], hi[k][0], hi[k][1], hi[k][2], hi[k][3]}
#pragma unroll
        for (int k = 0; k < 4; ++k) { const bf16x8 vf = PK(k);
            oA[d0] = __builtin_amdgcn_mfma_f32_32x32x16_bf16(pa[k], vf, oA[d0], 0, 0, 0);
            oB[d0] = __builtin_amdgcn_mfma_f32_32x32x16_bf16(pb[k], vf, oB[d0], 0, 0, 0);
            const s16x4 ha = d0 ? __builtin_shufflevector(pa[k], pa[k], 4, 5, 6, 7) : __builtin_shufflevector(pa[k], pa[k], 0, 1, 2, 3);
            const s16x4 hb = d0 ? __builtin_shufflevector(pb[k], pb[k], 4, 5, 6, 7) : __builtin_shufflevector(pb[k], pb[k], 0, 1, 2, 3);
            lsA = __builtin_amdgcn_mfma_f32_4x4x4bf16_1k(ha, ones, lsA, 0, 0, 0);
            lsB = __builtin_amdgcn_mfma_f32_4x4x4bf16_1k(hb, ones, lsB, 0, 0, 0); }
#undef PK
    }
}
__device__ __forceinline__ float own_sum(const f32x4& ls, int lane) { const int j = lane & 3; return j == 0 ? ls[0] : j == 1 ? ls[1] : j == 2 ? ls[2] : ls[3]; }
__device__ __forceinline__ void lazy_rescale(f32x4& ls, float& m, f32x16* o, LAS float* wf, int r32, int hi, int lane) {
    const float lt = halves_sum(own_sum(ls, lane));
    const int e = (int)((__float_as_uint(lt) >> 23) & 0xffu) - 127, d = e > 20 ? e : 0;
    const float f = __uint_as_float((unsigned)(127 - d) << 23);
    m += (float)d;
    if (hi == 0) wf[r32] = f;
    LDS_WAIT();
#pragma unroll
    for (int r = 0; r < 16; ++r) { const float fr_ = wf[crow(r, hi)]; o[0][r] *= fr_; o[1][r] *= fr_; }
    const f32x4 f4 = *(const LAS f32x4*)(wf + (r32 & ~3));
    ls *= f4;
    LDS_WAIT();
}
__device__ __forceinline__ void add_lut(f32x16& p0, f32x16& p1, const LAS float* lp) {
    f32x16 b0, b1;
#pragma unroll
    for (int r = 0; r < 16; ++r) { const int c = (r & 3) + 8 * (r >> 2); b0[r] = lp[59 - c]; b1[r] = lp[27 - c]; }
    __builtin_amdgcn_sched_barrier(0);
    p0 += b0; p1 += b1;
}

struct UnitP { const bf16_t* Qh; const bf16_t* Kh; const bf16_t* Vh; long seqrow0; int v0, tlo, thi, wd; };
template <int TYPE, bool G1> __device__ __forceinline__ void attn_unit_g(Frame& F, const UnitP P, bf16_t* Oh  , int opitch,
                                                              float lam, float one_m_laminit, const float* subg, float sink2, float* lse_out  ) {
    constexpr int NMAP = (TYPE == 0) ? 2 : 1;
    const int lane = F.lane_(), r32 = lane & 31, hi = lane >> 5, wid = F.wave;
    const unsigned lds0 = (unsigned)(uintptr_t)(F.lds + LDS_BIG);
    LAS float* wsf = (LAS float*)(F.lds + L_WSF) + wid * 128;
    const LAS float* lut = (const LAS float*)(F.lds + LDS_BIG + L_LUT);
    const int qlo = P.v0 + 32 * wid, qhi = qlo + 31;
    bf16x8 qr[4];
    { const bf16_t* Qw = P.Qh + (P.seqrow0 + qlo + r32) * 256;
#pragma unroll
      for (int d0 = 0; d0 < 4; ++d0) qr[d0] = *(const bf16x8*)(Qw + d0 * 16 + hi * 8); }
    const bf16_t* ksrc = P.Kh + (P.seqrow0 + lane) * 256 + wid * 8;
    const bf16_t* vsrc = P.Vh + (P.seqrow0 + 16 * (wid & 3) + (lane >> 2)) * 256 + (wid >> 2) * 32 + (lane & 3) * 8;
    const unsigned kdst = lds0 + L_K + wid * 1024, vdst = lds0 + L_V + wid * 1024;
    const lds_cptr kp0 = (lds_cptr)(F.lds + LDS_BIG) + L_K + hi * 1024 + r32 * 16;
    const int vb0 = (int)(lds0 + L_V) + ((lane >> 4) & 1) * 32 + (lane & 3) * 8 + (4 * hi + ((lane & 15) >> 2)) * 64;
    float m[NMAP], l[NMAP]; f32x16 o[NMAP][2]; f32x4 ls[NMAP];
#pragma unroll
    for (int mp = 0; mp < NMAP; ++mp) { m[mp] = 0.f; l[mp] = 0.f; o[mp][0] = f32x16{}; o[mp][1] = f32x16{}; ls[mp] = f32x4{}; }
#define DMA_TILE(t, slot) do { glds16(ksrc + (long)(t) * 64 * 256, (unsigned)__builtin_amdgcn_readfirstlane(kdst + (slot) * SLOTB)); glds16(vsrc + (long)(t) * 64 * 256, (unsigned)__builtin_amdgcn_readfirstlane(vdst + (slot) * SLOTB)); } while (0)
    DMA_TILE(P.tlo, 0);
#pragma unroll
    for (int d0 = 0; d0 < 4; ++d0) asm volatile("" : "+v"(qr[d0]));
    constexpr bool g1 = G1;
    bf16x8 pa[4], pb[4]; bool seen = false; (void)seen;
#define STAGE1(t_) do { \
        const lds_cptr kp = kp0 + slot * SLOTB; \
        const bool farc = (TYPE == 0) && (qlo - (k0 + 63) >= FAR_DIST); \
        const float cinit = farc ? lut[LUT_OFF + FAR_DIST + 64] : 0.f; \
        const LAS float* lp = lut + LUT_OFF + (qlo + r32 - k0 - 4 * hi - 59); \
        bf16x8 kf[8]; load_kfrags(kf, kp); \
        if (TYPE == 0) { \
            const bool first = ((t_) == P.tlo); \
            { f32x16 p0, p1; qkt_f<0, 2>(p0, p1, kf, qr, cinit - m[0]); if (!farc) add_lut(p0, p1, lp); if (first) first_ref(p0, p1, m[0]); exp_pack(p0, p1, pa); } \
            { f32x16 p0, p1; qkt_f<2, 2>(p0, p1, kf, qr, cinit - m[NMAP - 1]); if (!farc) add_lut(p0, p1, lp); if (first) first_ref(p0, p1, m[NMAP - 1]); exp_pack(p0, p1, pb); } \
        } else { \
            f32x16 p0, p1; qkt_f<0, 4>(p0, p1, kf, qr, cinit - m[0]);       \
            add_lut(p0, p1, lp); \
            softmax_pack_rel(p0, p1, m[0], l[0], o[0], wsf, r32, hi, pa, !seen); seen = true; \
        } } while (0)
#define STAGE2(vb_) do { \
        if (TYPE == 0) { \
            pv2s(o[0], o[NMAP - 1], ls[0], ls[NMAP - 1], (vb_), pa, pb); \
            const float mx = fmaxf(fmaxf(fmaxf(ls[0][0], ls[0][1]), fmaxf(ls[0][2], ls[0][3])), fmaxf(fmaxf(ls[NMAP - 1][0], ls[NMAP - 1][1]), fmaxf(ls[NMAP - 1][2], ls[NMAP - 1][3]))); \
            if (__any(mx > 0x1p40f)) { lazy_rescale(ls[0], m[0], o[0], wsf, r32, hi, lane); lazy_rescale(ls[NMAP - 1], m[NMAP - 1], o[NMAP - 1], wsf + 32, r32, hi, lane); } \
        } else pv(o[0], (vb_), pa[0], pa[1], pa[2], pa[3]); } while (0)
#define TILE_HEAD() \
        const int nslot = (slot == NSLOT - 1) ? 0 : slot + 1; \
        asm volatile("s_waitcnt vmcnt(0) lgkmcnt(0)\n\ts_barrier" ::: "memory");       \
        if (t + 1 < P.thi) DMA_TILE(t + 1, nslot); \
        const int k0 = 64 * t; \
        const bool act = (k0 <= qhi && k0 + 63 >= qlo - P.wd)
    int slot = 0;
    if (!g1) {
        for (int t = P.tlo; t < P.thi; ++t) { TILE_HEAD();
            if (act) { STAGE1(t); STAGE2(vb0 + slot * SLOTB); }
            slot = nslot; }
    } else {
        bool pend = false; int pvb = 0;
        for (int t = P.tlo; t < P.thi; ++t) { TILE_HEAD();
            if (pend) STAGE2(pvb);
            pend = act;
            if (act) { STAGE1(t); pvb = vb0 + slot * SLOTB; }
            slot = nslot; }
        if (pend) STAGE2(pvb);
    }
#undef TILE_HEAD
#undef STAGE1
#undef STAGE2
#undef DMA_TILE
    LAS float* stg = (LAS float*)(F.lds + LDS_BIG + L_OST + wid * OST_BYTES);
    float lt[NMAP];
#pragma unroll
    for (int mp = 0; mp < NMAP; ++mp) { lt[mp] = halves_sum(TYPE == 0 ? own_sum(ls[mp], lane) : l[mp]); if (TYPE == 1) lt[mp] += fast_exp2(sink2 - m[mp]); if (hi == 0) wsf[32 + 32 * mp + r32] = lt[mp]; }
    LDS_WAIT();
    if (TYPE == 0) {
        float la[16], lb2[16];
#pragma unroll
        for (int r = 0; r < 16; ++r) { la[r] = wsf[32 + crow(r, hi)]; lb2[r] = wsf[64 + crow(r, hi)]; }
        __builtin_amdgcn_sched_barrier(0);
#pragma unroll
        for (int r = 0; r < 16; ++r) { const int orow = crow(r, hi); const float i0 = fast_rcp(la[r]), i1 = fast_rcp(lb2[r]) * lam;
#pragma unroll
            for (int d0 = 0; d0 < 2; ++d0) stg[orow * 68 + d0 * 32 + r32] = o[0][d0][r] * i0 - o[NMAP - 1][d0][r] * i1; }
        LDS_WAIT();
        const int row = lane >> 1, half = lane & 1; const LAS float* sp = stg + row * 68 + half * 32;
        float v[32]; float ss = 0.f;
#pragma unroll
        for (int i = 0; i < 32; i += 4) { const f32x4 x = *(const LAS f32x4*)(sp + i); v[i] = x[0]; v[i + 1] = x[1]; v[i + 2] = x[2]; v[i + 3] = x[3]; ss += x[0] * x[0] + x[1] * x[1] + x[2] * x[2] + x[3] * x[3]; }
        ss += swz_xor<1>(ss);
        const float rs = rsqrtf(ss * (1.0f / 64.0f) + 1e-5f) * one_m_laminit;
        bf16_t* op = Oh + (P.seqrow0 + qlo + row) * (long)opitch + half * 32;
#pragma unroll
        for (int i = 0; i < 32; i += 8) { u32x4 w; const float* g = subg + half * 32 + i;
            w.x = cvt_pk_bf16(v[i] * rs * g[0], v[i + 1] * rs * g[1]); w.y = cvt_pk_bf16(v[i + 2] * rs * g[2], v[i + 3] * rs * g[3]);
            w.z = cvt_pk_bf16(v[i + 4] * rs * g[4], v[i + 5] * rs * g[5]); w.w = cvt_pk_bf16(v[i + 6] * rs * g[6], v[i + 7] * rs * g[7]);
            *(u32x4*)(op + i) = w; }
    } else {
        bf16_t* sb = (bf16_t*)0; LAS bf16_t* stb = (LAS bf16_t*)stg; (void)sb;
        float la[16];
#pragma unroll
        for (int r = 0; r < 16; ++r) la[r] = wsf[32 + crow(r, hi)];
        __builtin_amdgcn_sched_barrier(0);
#pragma unroll
        for (int r = 0; r < 16; ++r) { const int orow = crow(r, hi); const float i0 = fast_rcp(la[r]);
#pragma unroll
            for (int d0 = 0; d0 < 2; ++d0) stb[orow * 72 + d0 * 32 + r32] = f2bf(o[0][d0][r] * i0); }
        if (TYPE == 2 && hi == 0) lse_out[(P.seqrow0 + qlo + r32) * 4] = m[0] + __log2f(lt[0]);
        LDS_WAIT();
#pragma unroll
        for (int i = 0; i < 4; ++i) { const int row = i * 8 + (lane >> 3), ch = lane & 7; const u32x4 v = *(const LAS u32x4*)(stb + row * 72 + ch * 8);
            *(u32x4*)(Oh + (P.seqrow0 + qlo + row) * (long)opitch + ch * 8) = v; }
    }
    LDS_WAIT();
}
template <int TYPE> __device__ __forceinline__ void attn_unit(Frame& F, const UnitP P, bf16_t* Oh, int opitch, float lam, float one_m_laminit, const float* subg, float sink2, float* lse_out) {
    if (F.wave < 4) attn_unit_g<TYPE, false>(F, P, Oh, opitch, lam, one_m_laminit, subg, sink2, lse_out);
    else attn_unit_g<TYPE, true>(F, P, Oh, opitch, lam, one_m_laminit, subg, sink2, lse_out);
}
#undef SBAR
}


namespace dsel {
using att::lds_cptr; using att::crow;
constexpr int NQ = 16, CAND_CAP = 512;
constexpr int Q_T = 64, Q_NEED = 80, Q_SELCNT = 96, Q_CANDCNT = 112, Q_NB = 128, Q_ABOVE = 144, Q_B1 = 160, Q_FLAG = 176;
constexpr int RELD_OFF = 1280;
constexpr int WSF_OFF = 2048;
constexpr int SEL_OFF = LDS_AUX;
constexpr int BIASK_OFF = LDS_AUX + 16384;
constexpr int HIST_Q = 8200;
__device__ __forceinline__ unsigned okey(float s) { const unsigned u = __float_as_uint(s); return u ^ (((int)u >> 31) | 0x80000000u); }
struct Ctx { const bf16_t* misc; const bf16_t* iq; const bf16_t* ikc; long rowb; int q0, NT; };
__device__ __forceinline__ void load_kf(bf16x8 (&kf)[4], const Ctx& C, int t, int fr, int fq) {
    const bf16_t* kr = C.ikc + (C.rowb + 64 * t + fr) * 32 + 8 * fq;
#pragma unroll
    for (int g = 0; g < 4; ++g) kf[g] = *(const bf16x8*)(kr + g * 16 * 32);
}
#define FMA_ABS4(S, A, W) asm volatile("v_fma_f32 %0, |%4|, %8, %0\n\tv_fma_f32 %1, |%5|, %8, %1\n\tv_fma_f32 %2, |%6|, %8, %2\n\tv_fma_f32 %3, |%7|, %8, %3" \
        : "+v"(S[0]), "+v"(S[1]), "+v"(S[2]), "+v"(S[3]) : "v"(A[0]), "v"(A[1]), "v"(A[2]), "v"(A[3]), "v"(W))
__device__ __forceinline__ void score_tile(f32x4 (&sc)[4], const bf16x8 (&kf)[4], const bf16x8 (&iqf)[8], const bf16x8 (&cq)[2], const float (&w)[8]) {
    float s[4][4];
#pragma unroll
    for (int g = 0; g < 4; ++g) { f32x4 l = __builtin_amdgcn_mfma_f32_16x16x32_bf16(kf[g], cq[1], (f32x4){0.f, 0.f, 0.f, 0.f}, 0, 0, 0); l = __builtin_amdgcn_mfma_f32_16x16x32_bf16(kf[g], cq[0], l, 0, 0, 0);
#pragma unroll
        for (int r = 0; r < 4; ++r) s[g][r] = l[r]; }
#pragma unroll
    for (int h = 0; h < 8; ++h) {
        f32x4 a0 = __builtin_amdgcn_mfma_f32_16x16x32_bf16(kf[0], iqf[h], (f32x4){0.f, 0.f, 0.f, 0.f}, 0, 0, 0);
        f32x4 a1 = __builtin_amdgcn_mfma_f32_16x16x32_bf16(kf[1], iqf[h], (f32x4){0.f, 0.f, 0.f, 0.f}, 0, 0, 0);
        f32x4 a2 = __builtin_amdgcn_mfma_f32_16x16x32_bf16(kf[2], iqf[h], (f32x4){0.f, 0.f, 0.f, 0.f}, 0, 0, 0);
        f32x4 a3 = __builtin_amdgcn_mfma_f32_16x16x32_bf16(kf[3], iqf[h], (f32x4){0.f, 0.f, 0.f, 0.f}, 0, 0, 0);
#pragma unroll
        for (int r = 0; r < 4; ++r) { s[0][r] = __builtin_fmaf(__builtin_fabsf(a0[r]), w[h], s[0][r]); s[1][r] = __builtin_fmaf(__builtin_fabsf(a1[r]), w[h], s[1][r]);
                                      s[2][r] = __builtin_fmaf(__builtin_fabsf(a2[r]), w[h], s[2][r]); s[3][r] = __builtin_fmaf(__builtin_fabsf(a3[r]), w[h], s[3][r]); }
    }
#pragma unroll
    for (int g = 0; g < 4; ++g) sc[g] = (f32x4){s[g][0], s[g][1], s[g][2], s[g][3]};
}
#undef FMA_ABS4
template <int EMIT> __device__ __forceinline__ void tile_elems(const f32x4 (&sc)[4], int t, int fq, LAS unsigned char* hist, LAS unsigned* selbm, LAS unsigned* candcnt, unsigned T, int sh, unsigned msk) {
    unsigned eqm = 0u;
#pragma unroll
    for (int g = 0; g < 4; ++g)
#pragma unroll
        for (int r = 0; r < 4; ++r) {
            const unsigned key = okey(sc[g][r]);
            if (EMIT == 0) { if ((((key >> 21) ^ T) & msk) == 0u) __hip_atomic_fetch_add((LAS unsigned*)(hist + (((key >> sh) & 2047u) << 2)), 1u, __ATOMIC_RELAXED, __HIP_MEMORY_SCOPE_WORKGROUP); }
            else { const unsigned p = key >> sh;
                if (p > T) { const int kv = 64 * t + 16 * g + 4 * fq + r; __hip_atomic_fetch_or(selbm + (kv >> 5), 1u << (kv & 31), __ATOMIC_RELAXED, __HIP_MEMORY_SCOPE_WORKGROUP); }
                eqm |= (p == T) ? (1u << (4 * g + r)) : 0u; }
        }
    if (EMIT == 1 && eqm != 0u) {
        unsigned pos = __hip_atomic_fetch_add(candcnt, (unsigned)__builtin_popcount(eqm), __ATOMIC_RELAXED, __HIP_MEMORY_SCOPE_WORKGROUP);
#pragma unroll
        for (int g = 0; g < 4; ++g)
#pragma unroll
            for (int r = 0; r < 4; ++r) if ((eqm >> (4 * g + r)) & 1u) { if (pos < (unsigned)CAND_CAP) *(LAS u32x2*)(hist + pos * 8) = (u32x2){okey(sc[g][r]), (unsigned)(64 * t + 16 * g + 4 * fq + r)}; ++pos; }
    }
}
template <int EMIT> __device__ __forceinline__ void pass(Frame& F, const Ctx& C, const bf16x8 (&iqf)[8], const bf16x8 (&cq)[2], const float (&w)[8], unsigned T, int sh, unsigned msk) {
    const int lane = F.lane_(), fr = lane & 15, fq = lane >> 4;
    LAS unsigned* MQ = (LAS unsigned*)(F.lds + LDS_MISC);
    LAS unsigned char* hist = F.lds + LDS_BIG + fr * (EMIT ? 4096 : HIST_Q);
    LAS unsigned* selbm = (LAS unsigned*)(F.lds + SEL_OFF) + fr * 256;
    const int qpos = C.q0 + fr;
    bf16x8 kf0[4], kf1[4];
    const int t0 = F.wave;
    if (t0 < C.NT) load_kf(kf0, C, t0, fr, fq);
    if (t0 + 8 < C.NT) load_kf(kf1, C, t0 + 8, fr, fq);
#define D_TILE(KF, tt) do { f32x4 sc[4]; score_tile(sc, KF, iqf, cq, w); if ((tt) + 16 < C.NT) load_kf(KF, C, (tt) + 16, fr, fq); \
        if ((tt) == C.NT - 1) { _Pragma("unroll") for (int g = 0; g < 4; ++g) _Pragma("unroll") for (int r = 0; r < 4; ++r) sc[g][r] = (64 * (tt) + 16 * g + 4 * fq + r <= qpos) ? sc[g][r] : -__builtin_inff(); } \
        tile_elems<EMIT>(sc, (tt), fq, hist, selbm, MQ + Q_CANDCNT + fr, T, sh, msk); } while (0)
#pragma clang loop unroll(disable)
    for (int t = t0; t < C.NT; t += 16) {
        D_TILE(kf0, t);
        if (t + 8 < C.NT) D_TILE(kf1, t + 8);
    }
#undef D_TILE
}
__device__ __forceinline__ void scan_hist(Frame& F, int q, unsigned target, unsigned& bin, unsigned& above, unsigned& nb, unsigned& total) {
    const int lane = F.lane_();
    const LAS unsigned char* hq = F.lds + LDS_BIG + q * HIST_Q;
    const LAS u32x2* hp = (const LAS u32x2*)(hq + (63 - lane) * 128);
    unsigned c = 0;
    { u32x2 xv[16];
#pragma unroll
      for (int i = 0; i < 16; ++i) xv[i] = hp[(i + lane) & 15];
      __builtin_amdgcn_sched_barrier(0);
#pragma unroll
      for (int i = 0; i < 16; ++i) c += xv[i].x + xv[i].y; }
    const unsigned x = wave_incl_scan(c);
    total = (unsigned)__builtin_amdgcn_readlane((int)x, 63);
    const unsigned S = x - c;
    const unsigned long long bm = __ballot((S < target) && (x >= target));
    if (bm == 0ull) { bin = 0u; above = 0u; nb = 0u; return; }
    const int src = (int)__builtin_ctzll(bm);
    const unsigned Ssrc = (unsigned)__builtin_amdgcn_readlane((int)S, src);
    const unsigned cnt = lane < 32 ? *(const LAS unsigned*)(hq + ((63 - src) * 32 + 31 - lane) * 4) : 0u;
    const unsigned P = wave_incl_scan(cnt);
    const unsigned long long hm = __ballot(lane < 32 && Ssrc + P >= target);
    const int js = hm ? (int)__builtin_ctzll(hm) : 31;
    const unsigned cj = (unsigned)__builtin_amdgcn_readlane((int)cnt, js), Pj = (unsigned)__builtin_amdgcn_readlane((int)P, js);
    bin = (unsigned)((63 - src) * 32 + 31 - js); above = Ssrc + Pj - cj; nb = cj;
}
__device__ __forceinline__ void zero_hist(Frame& F, int tid) {
    LAS u32x4* z = (LAS u32x4*)(F.lds + LDS_BIG);
    const unsigned z0 = (unsigned)launder(0); const u32x4 zz = (u32x4){z0, z0, z0, z0};
#pragma unroll
    for (int i = 0; i < 16; ++i) z[tid + i * NTHREADS] = zz;
    if (tid < 8) z[16 * NTHREADS + tid] = zz;
}
__device__ __forceinline__ void d_unit(Frame& F, const bf16_t* R1, bf16_t* OBUF, int b, int q0, unsigned nxt_unit) {
    const int tid = F.tid_(), lane = tid & 63, fr = lane & 15, fq = lane >> 4, r32 = lane & 31, hi = lane >> 5, wid = F.wave;
    LAS unsigned* MQ = (LAS unsigned*)(F.lds + LDS_MISC);
    Ctx C; C.misc = R1 + (size_t)T_MISC * TILE_E; C.iq = R1 + (size_t)T_IQ * TILE_E; C.ikc = (const bf16_t*)(F.ws + WS_IKC); C.rowb = (long)b * SEQ; C.q0 = q0; C.NT = q0 / 64 + 1;
    zero_hist(F, tid);
    { LAS u32x4* zb = (LAS u32x4*)(F.lds + SEL_OFF); const unsigned z0 = (unsigned)launder(0); const u32x4 zz = (u32x4){z0, z0, z0, z0}; zb[tid] = zz; zb[tid + NTHREADS] = zz; }
    if (tid < 128) MQ[Q_T + tid] = 0u;
    bf16x8 iqf[8], cq[2]; float w[8];
    { const bf16_t* qrow = C.iq + (C.rowb + q0 + fr) * 256 + 8 * fq;
#pragma unroll
      for (int h = 0; h < 8; ++h) iqf[h] = *(const bf16x8*)(qrow + h * 32);
      const bf16x8 wv = *(const bf16x8*)(C.misc + (C.rowb + q0 + fr) * 256 + 160);
#pragma unroll
      for (int h = 0; h < 8; ++h) w[h] = bf2f((unsigned short)wv[h]);
#pragma unroll
      for (int j = 0; j < 8; ++j) { float c = 0.f;
#pragma unroll
          for (int h = 0; h < 8; ++h) c = __builtin_fmaf(w[h], bf2f((unsigned short)iqf[h][j]), c);
          const unsigned short ch = f2bf(c); cq[0][j] = (short)ch; cq[1][j] = (short)f2bf(c - bf2f(ch)); } }
    __syncthreads();
    if (tid == 0) MQ[9] = nxt_unit;
    pass<0>(F, C, iqf, cq, w, 0u, 21, 0u);
    __syncthreads();
    for (int qi = 0; qi < 2; ++qi) { const int q = 2 * wid + qi; unsigned bin, above, nb, total;
        scan_hist(F, q, 256u, bin, above, nb, total);
        if (lane == 0) {
            if (q0 + q + 1 <= 256) { MQ[Q_T + q] = 3u; MQ[Q_NEED + q] = 0u; MQ[Q_NB + q] = 0u; MQ[Q_ABOVE + q] = total; MQ[Q_B1 + q] = 0xffffffffu; }
            else { MQ[Q_T + q] = bin; MQ[Q_NEED + q] = 256u - above; MQ[Q_NB + q] = nb; MQ[Q_ABOVE + q] = above; MQ[Q_B1 + q] = bin;
                   if (nb > (unsigned)CAND_CAP && nb != 256u - above) MQ[Q_FLAG] = 1u; }
        } }
    __syncthreads();
    int shift = 21;
    if (MQ[Q_FLAG] != 0u) {
        __syncthreads();
        zero_hist(F, tid);
        __syncthreads();
        pass<0>(F, C, iqf, cq, w, MQ[Q_B1 + fr], 10, 0xffffffffu);
        __syncthreads();
        for (int qi = 0; qi < 2; ++qi) { const int q = 2 * wid + qi;
            const unsigned b1 = MQ[Q_B1 + q];
            if (b1 != 0xffffffffu) { unsigned bin, above, nb, total; const unsigned need1 = MQ[Q_NEED + q], ab1 = MQ[Q_ABOVE + q];
                scan_hist(F, q, need1, bin, above, nb, total);
                if (lane == 0) { MQ[Q_T + q] = (b1 << 11) | bin; MQ[Q_NEED + q] = need1 - above; MQ[Q_NB + q] = nb; MQ[Q_ABOVE + q] = ab1 + above; } }
            else if (lane == 0) MQ[Q_T + q] = (3u << 11) | 2047u; }
        shift = 10;
        __syncthreads();
    }
    pass<1>(F, C, iqf, cq, w, MQ[Q_T + fr], shift, 0u);
    __syncthreads();
    for (int qi = 0; qi < 2; ++qi) { const int q = 2 * wid + qi;
        unsigned need = MQ[Q_NEED + q]; unsigned n = MQ[Q_CANDCNT + q]; if (n > (unsigned)CAND_CAP) n = CAND_CAP;
        if (need > n) need = n;
        if (need > 0u) {
            const LAS u32x2* cd = (const LAS u32x2*)(F.lds + LDS_BIG + q * 4096);
            unsigned ck[8], ci[8]; unsigned alive = 0u, chosen = 0u;
#pragma unroll
            for (int s = 0; s < 8; ++s) { const unsigned j = lane + 64 * s; const u32x2 e = cd[j];
                const bool in = j < n; ck[s] = in ? e.x : 0u; ci[s] = in ? 8191u - e.y : 0u; alive |= in ? (1u << s) : 0u; }
            const int nsl = (int)((n + 63u) >> 6);
            if (need < n) {
                unsigned nalive = n;
                for (int bit = shift + 12; bit >= 0 && need > 0u && need < nalive; --bit) {
                    unsigned cnt1 = 0u; unsigned bits = 0u;
#pragma unroll
                    for (int s = 0; s < 8; ++s) if (s < nsl) { const unsigned v = (bit >= 13) ? (ck[s] >> (bit - 13)) : (ci[s] >> bit); const bool on = ((alive >> s) & 1u) && (v & 1u);
                        bits |= on ? (1u << s) : 0u; cnt1 += (unsigned)__builtin_popcountll(__ballot(on)); }
                    if (cnt1 >= need) { alive &= bits; nalive = cnt1; } else { chosen |= bits; need -= cnt1; alive &= ~bits; nalive -= cnt1; }
                }
                if (need > 0u) chosen |= alive;
            } else chosen = alive;
            LAS unsigned* selbm = (LAS unsigned*)(F.lds + SEL_OFF) + q * 256;
#pragma unroll
            for (int s = 0; s < 8; ++s) if (s < nsl) { if ((chosen >> s) & 1u) { const unsigned kv = 8191u - ci[s]; __hip_atomic_fetch_or(selbm + (kv >> 5), 1u << (kv & 31), __ATOMIC_RELAXED, __HIP_MEMORY_SCOPE_WORKGROUP); } }
        }
    }
    __syncthreads();
    {
        const unsigned lds0 = (unsigned)(uintptr_t)(F.lds + LDS_BIG) + wid * 16384;
        LAS float* wsf = (LAS float*)(F.lds + LDS_MISC + WSF_OFF) + wid * 64;
        LAS float* biasK = (LAS float*)(F.lds + BIASK_OFF) + wid * 256;
        const LAS float* relD = (const LAS float*)(F.lds + LDS_MISC + RELD_OFF);
        const lds_cptr kp = (lds_cptr)(F.lds + LDS_BIG) + wid * 16384 + hi * 1024 + r32 * 16;
        const int vb = (int)(lds0 + 8192) + ((lane >> 4) & 1) * 32 + (lane & 3) * 8 + (4 * hi + ((lane & 15) >> 2)) * 64;
        const bf16_t* dq = R1 + (size_t)T_DQ * TILE_E;
        int ksel2[2]; bf16x8 qr2[2][4];
#pragma unroll
        for (int qi = 0; qi < 2; ++qi) { const int q = 2 * wid + qi;
            LAS unsigned* selbm = (LAS unsigned*)(F.lds + SEL_OFF) + q * 256; LAS unsigned short* sel = (LAS unsigned short*)selbm;
            const u32x4 bw = *(const LAS u32x4*)(selbm + 4 * lane);
            const unsigned c = (unsigned)(__builtin_popcount(bw.x) + __builtin_popcount(bw.y) + __builtin_popcount(bw.z) + __builtin_popcount(bw.w));
            const unsigned x = wave_incl_scan(c);
            int ks = (int)__builtin_amdgcn_readlane((int)x, 63); ksel2[qi] = ks > 256 ? 256 : ks;
            unsigned pos = x - c;
            LDS_WAIT();
            unsigned wds[4] = {bw.x, bw.y, bw.z, bw.w};
#pragma unroll
            for (int i = 0; i < 4; ++i) { unsigned wv = wds[i]; while (wv) { const int bpos = __builtin_ctz(wv); wv &= wv - 1u; if (pos < 256u) sel[pos] = (unsigned short)(128 * lane + 32 * i + bpos); ++pos; } }
#pragma unroll
            for (int d0 = 0; d0 < 4; ++d0) { qr2[qi][d0] = (bf16x8){0, 0, 0, 0, 0, 0, 0, 0}; if (r32 < 4) qr2[qi][d0] = *(const bf16x8*)(dq + (C.rowb + q0 + q) * 256 + r32 * 64 + d0 * 16 + hi * 8); } }
        asm volatile("s_waitcnt vmcnt(0) lgkmcnt(0)" ::: "memory");
        const int nt0 = (ksel2[0] + 63) >> 6, nt1 = (ksel2[1] + 63) >> 6, ntot = nt0 + nt1;
#define D_ISSUE_K(s_) do { const int qi_ = (s_) >= nt0 ? 1 : 0, tt_ = (s_) - (qi_ ? nt0 : 0); const int ks_ = qi_ ? ksel2[1] : ksel2[0]; const int qpos_ = q0 + 2 * wid + qi_; \
            const LAS unsigned short* sel_ = (const LAS unsigned short*)(F.lds + SEL_OFF) + (2 * wid + qi_) * 512; \
            const int j_ = 64 * tt_ + lane; const bool valid_ = j_ < ks_; const int idx_ = valid_ ? (int)sel_[j_] : 0; const bf16_t* krow_ = C.misc + (C.rowb + idx_) * 256; \
            _Pragma("unroll") for (int c_ = 0; c_ < 8; ++c_) att::glds16(krow_ + c_ * 8, (unsigned)__builtin_amdgcn_readfirstlane(lds0 + c_ * 1024)); \
            const int bk_ = t5_bucket(qpos_ - idx_); const f32x4 rb_ = *(const LAS f32x4*)(relD + bk_ * 4); const float ninf_ = -__builtin_inff(); \
            *(LAS f32x4*)(biasK + lane * 4) = valid_ ? rb_ : (f32x4){ninf_, ninf_, ninf_, ninf_}; } while (0)
#define D_ISSUE_V(s_) do { const int qi_ = (s_) >= nt0 ? 1 : 0, tt_ = (s_) - (qi_ ? nt0 : 0); const int ks_ = qi_ ? ksel2[1] : ksel2[0]; \
            const LAS unsigned short* sel_ = (const LAS unsigned short*)(F.lds + SEL_OFF) + (2 * wid + qi_) * 512; \
            int iv_[4];         \
            _Pragma("unroll") for (int p_ = 0; p_ < 4; ++p_) { const int jr_ = 64 * tt_ + 16 * p_ + (lane >> 2); iv_[p_] = (int)sel_[jr_ < ks_ ? jr_ : 0]; } \
            __builtin_amdgcn_sched_barrier(0); \
            _Pragma("unroll") for (int p_ = 0; p_ < 4; ++p_) { const int jr_ = 64 * tt_ + 16 * p_ + (lane >> 2); iv_[p_] = jr_ < ks_ ? iv_[p_] : 0; } \
            _Pragma("unroll") for (int p_ = 0; p_ < 8; ++p_) \
                att::glds16(C.misc + (C.rowb + iv_[p_ & 3]) * 256 + 64 + (p_ >> 2) * 32 + (lane & 3) * 8, (unsigned)__builtin_amdgcn_readfirstlane(lds0 + 8192 + p_ * 1024)); } while (0)
        float m = -1e30f, l = 0.f; f32x16 o[2]; o[0] = f32x16{}; o[1] = f32x16{};
        if (ntot > 0) { D_ISSUE_K(0); D_ISSUE_V(0); }
        for (int s = 0; s < ntot; ++s) {
            const int qi = s >= nt0 ? 1 : 0; const bool lastt = (s == nt0 - 1) || (s == ntot - 1); const bool has_next = s + 1 < ntot;
            asm volatile("s_waitcnt vmcnt(8) lgkmcnt(0)" ::: "memory");
            f32x16 p0, p1; if (qi) att::qkt<0, 4>(p0, p1, kp, qr2[1], 0.f); else att::qkt<0, 4>(p0, p1, kp, qr2[0], 0.f);
#pragma unroll
            for (int r = 0; r < 16; ++r) { const int kv = crow(r, hi); p0[r] += biasK[kv * 4 + (r32 & 3)]; p1[r] += biasK[(kv + 32) * 4 + (r32 & 3)]; }
            LDS_WAIT();
            if (has_next) { D_ISSUE_K(s + 1); asm volatile("s_waitcnt vmcnt(8)" ::: "memory"); } else asm volatile("s_waitcnt vmcnt(0)" ::: "memory");
            att::softmax_pv(p0, p1, m, l, o, vb, wsf, r32, hi);
            LDS_WAIT();
            if (lastt) {
                const float lt = att::halves_sum(l);
                if (hi == 0) wsf[32 + r32] = lt;
                LDS_WAIT();
                const long grow = C.rowb + q0 + 2 * wid + qi;
                if (hi == 0) {
#pragma unroll
                    for (int r = 0; r < 4; ++r) { const float il = fast_rcp(wsf[32 + r]);
                        OBUF[grow * 1024 + 768 + r * 64 + r32] = f2bf(o[0][r] * il); OBUF[grow * 1024 + 768 + r * 64 + 32 + r32] = f2bf(o[1][r] * il); } }
                LDS_WAIT();
                m = -1e30f; l = 0.f; o[0] = f32x16{}; o[1] = f32x16{};
            }
            if (has_next) D_ISSUE_V(s + 1);
        }
        asm volatile("s_waitcnt vmcnt(0) lgkmcnt(0)" ::: "memory");
#undef D_ISSUE_K
#undef D_ISSUE_V
    }
}
}

constexpr int NU_A = 512, NU_D = 2048, NU_B = 512, NU_C = 1536, NU_ATT = NU_A + NU_D + NU_B + NU_C;
__device__ __forceinline__ void build_lut(Frame& F, const float* rel, int type, int h, int g) {
    LAS float* lut = (LAS float*)(F.lds + LDS_BIG + att::L_LUT);
    const float ninf = -__builtin_inff();
    for (int idx = F.tid_(); idx < att::LUT_N; idx += NTHREADS) { const int d = idx - att::LUT_OFF; float v;
        if (type == 0) v = d < 0 ? ninf : rel[t5_bucket(d) * NBH + h] * LOG2E;
        else if (type == 1) v = (d < 0 || d > 127) ? ninf : rel[t5_bucket(d) * NBH + 4 + h] * LOG2E;
        else v = (d < 0 || d > 128) ? ninf : rel[t5_bucket(d << (2 * g)) * NBH + 8 + 4 * g + h] * LOG2E;
        lut[idx] = v; }
}
#define ATT_FETCH_BEGIN() unsigned nxt_unit = 0u; if (F.tid_() == 0) nxt_unit = __hip_atomic_fetch_add(F.ctl + CW_QATT + 64 * l, 1u, RLX_AGENT); __syncthreads()
#define ATT_FETCH_END() __syncthreads(); if (F.tid_() == 0) MQ[8] = nxt_unit; __syncthreads(); n = (int)MQ[8]
__device__ __forceinline__ void attention_phase(Frame& F, const Args& a, int l) {
    bf16_t* const R1 = (bf16_t*)(F.ws + WS_R1); bf16_t* const OBUF = (bf16_t*)(F.ws + WS_OBUF);
    LAS unsigned* MQ = (LAS unsigned*)(F.lds + LDS_MISC);
    const float* rel = a.in[IN_REL];
    { const int t_ = F.tid_(); if (t_ < 128) ((LAS float*)(F.lds + LDS_MISC + dsel::RELD_OFF))[t_] = rel[(t_ >> 2) * NBH + 20 + (t_ & 3)] * LOG2E; }
    __syncthreads();
    if (F.tid_() == 0) MQ[8] = __hip_atomic_fetch_add(F.ctl + CW_QATT + 64 * l, 1u, RLX_AGENT);
    __syncthreads();
    int n = (int)MQ[8]; int lutkey = -1;
    {   const float lam = ((const float*)(F.ws + WS_LAM))[l], one_m = 1.0f - ((const float*)(F.ws + WS_LAM))[2 + l];
        while (n < NU_A) { ATT_FETCH_BEGIN();
            const int qb = 31 - (n >> 4), b = (n >> 2) & 3, h = n & 3;
            if (lutkey != h) { build_lut(F, rel, 0, h, 0); lutkey = h; } __syncthreads();
            att::UnitP P{R1 + (size_t)T_AQ * TILE_E + h * 64, R1 + (size_t)T_AK * TILE_E + h * 64, R1 + (size_t)T_AV * TILE_E + h * 64, (long)b * SEQ, qb * 256, 0, 4 * qb + 4, 1 << 30};
            att::attn_unit<0>(F, P, OBUF + h * 64, 1024, lam, one_m, a.in[IN_SUBLN] + l * 64, 0.f, nullptr);
            ATT_FETCH_END(); } }
    F.ws = (unsigned char*)launder_s((GAS unsigned char*)F.ws);
    while (n < NU_A + NU_D) { ATT_FETCH_BEGIN();
        const int i = n - NU_A; const int b = i >> 9, blk = 511 - (i & 511);
        dsel::d_unit(F, (bf16_t*)(F.ws + WS_R1), (bf16_t*)(F.ws + WS_OBUF), b, blk * 16, nxt_unit);
        __syncthreads(); n = (int)MQ[9]; lutkey = -1; }
    F.ws = (unsigned char*)launder_s((GAS unsigned char*)F.ws);
    while (n < NU_A + NU_D + NU_B) { ATT_FETCH_BEGIN();
        bf16_t* const R1b = (bf16_t*)(F.ws + WS_R1);
        const int j = n - NU_A - NU_D; const int qb = j & 31, b = (j >> 5) & 3, h = j >> 7;
        if (lutkey != 16 + h) { build_lut(F, rel, 1, h, 0); lutkey = 16 + h; } __syncthreads();
        const bf16_t* kv = R1b + (size_t)T_BKV * TILE_E + (h >> 1) * 64;
        att::UnitP P{R1b + (size_t)T_BQ * TILE_E + h * 64, kv, kv + 128, (long)b * SEQ, qb * 256, (4 * qb - 2) > 0 ? 4 * qb - 2 : 0, 4 * qb + 4, 127};
        att::attn_unit<1>(F, P, (bf16_t*)(F.ws + WS_OBUF) + 256 + h * 64, 1024, 0.f, 0.f, nullptr, a.in[IN_SINKS][l * 4 + h] * LOG2E, nullptr);
        ATT_FETCH_END(); }
    F.ws = (unsigned char*)launder_s((GAS unsigned char*)F.ws);
    while (n < NU_ATT) { ATT_FETCH_BEGIN();
        bf16_t* const R1c = (bf16_t*)(F.ws + WS_R1);
        const int j = n - NU_A - NU_D - NU_B; const int g = j >> 9, jj = j & 511, h = jj >> 7, blk = jj & 127, b = blk >> 5, vbk = blk & 31;
        const int lg = 2 * g, Lg = SEQ >> lg, vrow = vbk * 256, rho = vrow >> (13 - lg), v0 = vrow & (Lg - 1);
        if (lutkey != 32 + 4 * g + h) { build_lut(F, rel, 2, h, g); lutkey = 32 + 4 * g + h; } __syncthreads();
        bf16_t* qh = R1c + (size_t)(T_CQ + g) * TILE_E + h * 64;
        const int t0 = v0 / 64;
        att::UnitP P{qh, R1c + (size_t)(T_CK + g) * TILE_E + h * 64, R1c + (size_t)(T_CV + g) * TILE_E + h * 64, (long)b * SEQ + (long)rho * Lg, v0, (t0 - 2) > 0 ? t0 - 2 : 0, t0 + 4, 128};
        att::attn_unit<2>(F, P, qh, 256, 0.f, 0.f, nullptr, 0.f, (float*)(F.ws + WS_LSE) + (size_t)g * M * 4 + h);
        ATT_FETCH_END(); }
}
#undef ATT_FETCH_BEGIN
#undef ATT_FETCH_END

constexpr int PPL = 11;
constexpr int N_PHASES = 1 + PPL * DEPTH;


__device__ __forceinline__ void cvt_item(const float* src, int ldsrc, int srccol, int ncols, int k0, bf16_t* dstrow0, int Kdst, LAS float* scr, int lane) {
    const int c = lane & 31;
    float tv[32];
#pragma unroll
    for (int i = 0; i < 32; ++i) { const int kk = 2 * i + (lane >> 5); tv[i] = (c < ncols) ? src[(size_t)(k0 + kk) * ldsrc + srccol + c] : 0.f; }
#pragma unroll
    for (int i = 0; i < 32; ++i) { const int kk = 2 * i + (lane >> 5); scr[kk * 33 + c] = tv[i]; }
    LDS_WAIT(); asm volatile("" ::: "memory");
    const int c8 = lane & 7;
#pragma unroll
    for (int j = 0; j < 4; ++j) { const int n = (lane >> 3) + 8 * j; const LAS float* s = scr + (8 * c8) * 33 + n;
        u32x4 o; o.x = cvt_pk_bf16(s[0 * 33], s[1 * 33]); o.y = cvt_pk_bf16(s[2 * 33], s[3 * 33]); o.z = cvt_pk_bf16(s[4 * 33], s[5 * 33]); o.w = cvt_pk_bf16(s[6 * 33], s[7 * 33]);
        *(GAS u32x4*)(dstrow0 + (size_t)n * Kdst + k0 + 8 * c8) = o; }
    LDS_WAIT(); asm volatile("" ::: "memory");
}
__device__ __forceinline__ void win_colmap(int n0, int& srccol, int& ncols) {
    ncols = 32;
    if (n0 < 3968) srccol = n0;
    else if (n0 < 4000) srccol = 4224 + (n0 - 3968);
    else if (n0 == 4000) { srccol = 4256; ncols = 8; }
    else if (n0 < 4096) { srccol = 0; ncols = 0; }
    else if (n0 < 4352) srccol = 3968 + (n0 - 4096);
    else srccol = 4264 + (n0 - 4352);
}
__device__ __forceinline__ void p0_prologue(Frame& F, const Args& a) {
    const int tid = F.tid_(), lane = tid & 63;
    LAS float* sil = (LAS float*)(F.lds + LDS_BIG);
    LAS float* red = (LAS float*)(F.lds + LDS_BIG + 16384);
    float* mod = (float*)(F.ws + WS_MOD);
    if (F.vcu < 192) {
        { float cv[8];
#pragma unroll
          for (int k = 0; k < 8; ++k) cv[k] = a.in[IN_C][tid + k * NTHREADS];
#pragma unroll
          for (int k = 0; k < 8; ++k) sil[tid + k * NTHREADS] = cv[k] * sigmoidf_(cv[k]); }
        __syncthreads();
        for (int it = F.vcu; it < 192; it += F.G) {
            const int l = it / 96, cg = it % 96, col = cg * 64 + lane;
            const float* w = a.in[IN_WADA] + (size_t)l * D * 6144 + col;
            float acc0 = 0.f, acc1 = 0.f, acc2 = 0.f, acc3 = 0.f;
            const int kb = F.wave * 128;
#pragma unroll 16
            for (int kk = 0; kk < 128; ++kk) { const int k = kb + kk; const float wv = w[(size_t)k * 6144];
                acc0 += sil[k] * wv; acc1 += sil[1024 + k] * wv; acc2 += sil[2048 + k] * wv; acc3 += sil[3072 + k] * wv; }
            red[(F.wave * 4 + 0) * 64 + lane] = acc0; red[(F.wave * 4 + 1) * 64 + lane] = acc1; red[(F.wave * 4 + 2) * 64 + lane] = acc2; red[(F.wave * 4 + 3) * 64 + lane] = acc3;
            __syncthreads();
            if (tid < 256) { const int b = tid >> 6, ln = tid & 63; float s = 0.f;
#pragma unroll
                for (int w8 = 0; w8 < 8; ++w8) s += red[(w8 * 4 + b) * 64 + ln];
                mod[((size_t)l * 4 + b) * 6144 + cg * 64 + ln] = s + a.in[IN_BADA][(size_t)l * 6144 + cg * 64 + ln]; }
            __syncthreads();
        }
    }
    if (F.vcu == 255 % F.G && F.wave == 0) {
        float* lam = (float*)(F.ws + WS_LAM);
        for (int l = 0; l < DEPTH; ++l) {
            const float* lq = a.in[IN_LAMQ] + l * 64; const float* lk = a.in[IN_LAMK] + l * 64;
            float p0 = lane < 32 ? lq[lane] * lk[lane] : 0.f, p1 = lane < 32 ? lq[32 + lane] * lk[32 + lane] : 0.f;
            p0 = wave_sum(p0); p1 = wave_sum(p1);
            const float lam_init = 0.8f - 0.6f * expf(-0.3f * (float)l);
            if (lane == 0) { lam[l] = expf(p0) - expf(p1) + lam_init; lam[2 + l] = lam_init; }
        }
    }
    __syncthreads();
    LAS float* scr = (LAS float*)(F.lds + LDS_BIG + F.wave * 16384);
    const int gw = F.vcu * NWAVES + F.wave, NGW = F.G * NWAVES;
    constexpr int I_A = 2 * 16 * 264, I_B = 2 * 4 * 4 * 32, I_C = 2 * 16 * 32, I_D = 2 * 16 * 16 * 16, I_E = 2 * 16 * 4 * 32;
    for (int it = gw; it < I_A + I_B + I_C + I_D + I_E; it += NGW) {
        int r = it;
        if (r < I_A) { const int l = r / 4224, q = r % 4224, kb = q / 264, nb = q % 264; int sc, nc; win_colmap(nb * 32, sc, nc);
            cvt_item(a.in[IN_WIN] + (size_t)l * D * INW, INW, sc, nc, kb * 64, (bf16_t*)(F.ws + WS_WIN) + ((size_t)l * NWIN + nb * 32) * D, D, scr, lane); continue; }
        r -= I_A;
        if (r < I_B) { const int li = r / 128, q = r % 128, kb = q / 32, nb = q % 32;
            cvt_item(a.in[IN_WBRANCH] + (size_t)li * 256 * D, D, nb * 32, 32, kb * 64, (bf16_t*)(F.ws + WS_WB) + ((size_t)li * D + nb * 32) * 256, 256, scr, lane); continue; }
        r -= I_B;
        if (r < I_C) { const int l = r / 512, q = r % 512, kb = q / 32, nb = q % 32;
            cvt_item(a.in[IN_WOUT] + (size_t)l * D * D, D, nb * 32, 32, kb * 64, (bf16_t*)(F.ws + WS_WO) + ((size_t)l * D + nb * 32) * D, D, scr, lane); continue; }
        r -= I_C;
        if (r < I_D) { const int le = r / 256, q = r % 256, kb = q / 16, nb = q % 16;
            const int n0 = nb * 32, ct = n0 >> 8, wi = n0 & 255; const float* src = (wi < 128 ? a.in[IN_WEG] : a.in[IN_WEU]) + (size_t)le * D * FFE;
            cvt_item(src, FFE, ct * 128 + (wi & 127), 32, kb * 64, (bf16_t*)(F.ws + WS_W1) + ((size_t)le * 512 + n0) * D, D, scr, lane); continue; }
        r -= I_D;
        { const int le = r / 128, q = r % 128, kb = q / 32, nb = q % 32;
            cvt_item(a.in[IN_WED] + (size_t)le * FFE * D, D, nb * 32, 32, kb * 64, (bf16_t*)(F.ws + WS_W2) + ((size_t)le * D + nb * 32) * FFE, FFE, scr, lane); }
    }
}
__device__ __forceinline__ void modulate_rows(Frame& F, const float* x, const float* modl  , int shift_idx, int scale_idx, bf16_t* out) {
    const int lane = F.lane_(); const int gw = F.vcu * NWAVES + F.wave, NGW = F.G * NWAVES;
    constexpr int RPW = 16;
    for (int chunk = gw; chunk < M / RPW; chunk += NGW) {
        const int m0 = chunk * RPW; const float* mb = modl + (size_t)(m0 >> 13) * 6144;
        f32x4 sc1[4], shv[4], xn[4];
#pragma unroll
        for (int j = 0; j < 4; ++j) { const int c = 4 * lane + 256 * j; sc1[j] = *(const f32x4*)(mb + scale_idx * D + c) + 1.0f; shv[j] = *(const f32x4*)(mb + shift_idx * D + c);
            xn[j] = ((const GAS f32x4*)(x + (size_t)m0 * D) + lane)[64 * j]; }
        for (int i = 0; i < RPW; ++i) { const int m = m0 + i;
            f32x4 xv[4];
#pragma unroll
            for (int j = 0; j < 4; ++j) xv[j] = xn[j];
            if (i + 1 < RPW) {
#pragma unroll
                for (int j = 0; j < 4; ++j) xn[j] = ((const GAS f32x4*)(x + (size_t)(m + 1) * D) + lane)[64 * j]; }
            GAS unsigned long long* o8 = (GAS unsigned long long*)(out + (size_t)m * D) + lane;
#pragma unroll
            for (int j = 0; j < 4; ++j) { const f32x4 r = xv[j] * sc1[j] + shv[j];
                o8[64 * j] = (unsigned long long)cvt_pk_bf16(r[0], r[1]) | ((unsigned long long)cvt_pk_bf16(r[2], r[3]) << 32); }
        }
    }
}
__device__ __forceinline__ void combine_c(Frame& F) {
    const int lane = F.lane_(); const int gw = F.vcu * NWAVES + F.wave, NGW = F.G * NWAVES;
    const bf16_t* R1 = (const bf16_t*)(F.ws + WS_R1); bf16_t* OB = (bf16_t*)(F.ws + WS_OBUF); const float* lse = (const float*)(F.ws + WS_LSE);
    const int h = lane >> 4;
    float lsn[3]; u32x2 ovn[3];
    if (gw < M) {
#pragma unroll
        for (int g = 0; g < 3; ++g) { const size_t pr = (size_t)pg8::perm_row(gw, 2 * g); lsn[g] = lse[((size_t)g * M + pr) * 4 + h]; ovn[g] = *(const u32x2*)(R1 + (size_t)(T_CQ + g) * TILE_E + pr * 256 + 4 * lane); } }
    for (int m = gw; m < M; m += NGW) {
        float ls[3]; u32x2 ov[3];
#pragma unroll
        for (int g = 0; g < 3; ++g) { ls[g] = lsn[g]; ov[g] = ovn[g]; }
        if (m + NGW < M) {
#pragma unroll
            for (int g = 0; g < 3; ++g) { const size_t pr = (size_t)pg8::perm_row(m + NGW, 2 * g); lsn[g] = lse[((size_t)g * M + pr) * 4 + h]; ovn[g] = *(const u32x2*)(R1 + (size_t)(T_CQ + g) * TILE_E + pr * 256 + 4 * lane); } }
        const float mx = fmaxf(fmaxf(ls[0], ls[1]), ls[2]);
        float w[3]; float ws = 0.f;
#pragma unroll
        for (int g = 0; g < 3; ++g) { w[g] = fast_exp2(ls[g] - mx); ws += w[g]; }
        const float iw = 1.0f / ws; float o0 = 0.f, o1 = 0.f, o2 = 0.f, o3 = 0.f;
#pragma unroll
        for (int g = 0; g < 3; ++g) { const float wg = w[g] * iw; o0 += wg * bflo(ov[g].x); o1 += wg * bfhi(ov[g].x); o2 += wg * bflo(ov[g].y); o3 += wg * bfhi(ov[g].y); }
        *(u32x2*)(OB + (size_t)m * 1024 + 512 + 4 * lane) = (u32x2){cvt_pk_bf16(o0, o1), cvt_pk_bf16(o2, o3)};
    }
}
constexpr int LN_ROUTE_OFF = LDS_AUX;
__device__ __forceinline__ void ln1_phase(Frame& F, const Args& a, int l, const float* xin, float* xout, const bf16_t* y, bf16_t* vout) {
    const int tid = F.tid_(), lane = tid & 63, wid = F.wave;
    LAS float* wrt = (LAS float*)(F.lds + LDS_BIG);
    LAS unsigned* re = (LAS unsigned*)(F.lds + LN_ROUTE_OFF); LAS float* rw = (LAS float*)(F.lds + LN_ROUTE_OFF + 1024); LAS unsigned* lbase = (LAS unsigned*)(F.lds + LN_ROUTE_OFF + 2048);
    {   float t_[32];
#pragma unroll
        for (int k = 0; k < 32; ++k) { const int i = tid + k * NTHREADS; t_[k] = a.in[IN_WROUTER][(i & 1023) * 16 + (i >> 10)]; }
#pragma unroll
        for (int k = 0; k < 32; ++k) wrt[tid + k * NTHREADS] = t_[k]; }
    __syncthreads();
    const float* modl = (const float*)(F.ws + WS_MOD) + (size_t)l * 4 * 6144;
    const float* lg = a.in[IN_LN1G] + l * D; const float* lb = a.in[IN_LN1B] + l * D;
    unsigned* liste = (unsigned*)(F.ws + WS_LISTE); float* listw = (float*)(F.ws + WS_LISTW);
    gu32* ecnt = F.ctl + CW_ECNT + 1024 * l;
    for (int chunk = F.vcu; chunk < M / 128; chunk += F.G) {
        f32x4 ga1[4], lgv[4], lbv[4], sc1[4], shv[4];
        const int eL = ((lane & 1) << 3) | ((lane & 2) << 1) | ((lane & 4) >> 1) | ((lane & 8) >> 3), gL = eL >> 2;
        const float brtl = a.in[IN_BROUTER][eL];
        { const float* mbc = modl + (size_t)((chunk * 128) >> 13) * 6144;
#pragma unroll
          for (int j = 0; j < 4; ++j) { const int c = 4 * lane + 256 * j; ga1[j] = *(const f32x4*)(mbc + 2 * D + c) + 1.0f; lgv[j] = *(const f32x4*)(lg + c); lbv[j] = *(const f32x4*)(lb + c);
              sc1[j] = *(const f32x4*)(mbc + 4 * D + c) + 1.0f; shv[j] = *(const f32x4*)(mbc + 3 * D + c); } }
        f32x4 xn[4]; u32x2 yn[4];
        { const int m0 = chunk * 128 + wid * 16;
#pragma unroll
          for (int j = 0; j < 4; ++j) { const int c = 4 * lane + 256 * j; xn[j] = *(const f32x4*)(xin + (size_t)m0 * D + c); yn[j] = *(const u32x2*)(y + (size_t)m0 * D + c); } }
        for (int i = 0; i < 16; ++i) {
            const int rl = wid * 16 + i, m = chunk * 128 + rl;
            f32x4 z[4]; float s = 0.f;
#pragma unroll
            for (int j = 0; j < 4; ++j) { const f32x4 xv = xn[j]; const u32x2 yv = yn[j];
                z[j] = xv * ALPHA + ga1[j] * (f32x4){bflo(yv.x), bfhi(yv.x), bflo(yv.y), bfhi(yv.y)}; s += (z[j][0] + z[j][1]) + (z[j][2] + z[j][3]); }
            if (i + 1 < 16) {
#pragma unroll
                for (int j = 0; j < 4; ++j) { const int c = 4 * lane + 256 * j; xn[j] = *(const f32x4*)(xin + (size_t)(m + 1) * D + c); yn[j] = *(const u32x2*)(y + (size_t)(m + 1) * D + c); } }
            const float mean = wave_sum(s) * (1.f / D); float s2 = 0.f;
#pragma unroll
            for (int j = 0; j < 4; ++j) { z[j] = z[j] - mean; s2 += (z[j][0] * z[j][0] + z[j][1] * z[j][1]) + (z[j][2] * z[j][2] + z[j][3] * z[j][3]); }
            const float rstd = rsqrtf(wave_sum(s2) * (1.f / D) + LN_EPS);
            float lgt[16];
#pragma unroll
            for (int e = 0; e < 16; ++e) lgt[e] = 0.f;
#pragma unroll
            for (int j = 0; j < 4; ++j) { const int c = 4 * lane + 256 * j;
                const f32x4 x1 = z[j] * rstd * lgv[j] + lbv[j];
                *(f32x4*)(xout + (size_t)m * D + c) = x1;
                const f32x4 v = x1 * sc1[j] + shv[j];
                *(u32x2*)(vout + (size_t)m * D + c) = (u32x2){cvt_pk_bf16(v[0], v[1]), cvt_pk_bf16(v[2], v[3])};
                f32x4 wv[16];
#pragma unroll
                for (int e = 0; e < 16; ++e) wv[e] = *(const LAS f32x4*)(wrt + e * 1024 + c);
                __builtin_amdgcn_sched_barrier(0);
#pragma unroll
                for (int e = 0; e < 16; ++e) lgt[e] = __builtin_fmaf(v[0], wv[e][0], __builtin_fmaf(v[1], wv[e][1], __builtin_fmaf(v[2], wv[e][2], __builtin_fmaf(v[3], wv[e][3], lgt[e])))); }
            float r1[8], r2[4], r3[2], r4;
            { const bool b0 = lane & 1, b1 = lane & 2, b2 = lane & 4, b3 = lane & 8;
#pragma unroll
              for (int j = 0; j < 8; ++j) { const float snd = b0 ? lgt[j] : lgt[j + 8], kp = b0 ? lgt[j + 8] : lgt[j]; r1[j] = kp + swz_xor<1>(snd); }
#pragma unroll
              for (int j = 0; j < 4; ++j) { const float snd = b1 ? r1[j] : r1[j + 4], kp = b1 ? r1[j + 4] : r1[j]; r2[j] = kp + swz_xor<2>(snd); }
#pragma unroll
              for (int j = 0; j < 2; ++j) { const float snd = b2 ? r2[j] : r2[j + 2], kp = b2 ? r2[j + 2] : r2[j]; r3[j] = kp + swz_xor<4>(snd); }
              { const float snd = b3 ? r3[0] : r3[1], kp = b3 ? r3[1] : r3[0]; r4 = kp + swz_xor<8>(snd); }
              r4 += swz_xor<16>(r4);
              auto rr = __builtin_amdgcn_permlane32_swap(__float_as_uint(r4), __float_as_uint(r4), false, false); r4 = __uint_as_float(rr[0]) + __uint_as_float(rr[1]); }
            float mxl = fmaxf(r4, swz_xor<1>(r4)); mxl = fmaxf(mxl, swz_xor<2>(mxl)); mxl = fmaxf(mxl, swz_xor<4>(mxl)); mxl = fmaxf(mxl, swz_xor<8>(mxl));
            const float pe = __expf(r4 - mxl);
            float ps = pe + swz_xor<1>(pe); ps += swz_xor<2>(ps); ps += swz_xor<4>(ps); ps += swz_xor<8>(ps);
            const float prl = pe * (1.0f / ps), sll = prl + brtl;
            const float sb = swz_xor<4>(sll), sc_ = swz_xor<8>(sll), sd = swz_xor<8>(sb);
            const float hi1 = fmaxf(sll, sb), lo1 = fminf(sll, sb), hi2 = fmaxf(sc_, sd), lo2 = fminf(sc_, sd);
            float bgs = fmaxf(hi1, hi2) + fmaxf(fminf(hi1, hi2), fmaxf(lo1, lo2)); int bg = gL;
            { const float og = swz_xor<1>(bgs); const int oi = __builtin_amdgcn_update_dpp(0, bg, 0xB1, 0xf, 0xf, false); const bool tk = (og > bgs) || (og == bgs && oi < bg); bgs = tk ? og : bgs; bg = tk ? oi : bg; }
            { const float og = swz_xor<2>(bgs); const int oi = __builtin_amdgcn_update_dpp(0, bg, 0x4E, 0xf, 0xf, false); const bool tk = (og > bgs) || (og == bgs && oi < bg); bgs = tk ? og : bgs; bg = tk ? oi : bg; }
            const int rk = (int)((sb > sll) || (sb == sll && (eL ^ 2) < eL)) + (int)((sc_ > sll) || (sc_ == sll && (eL ^ 1) < eL)) + (int)((sd > sll) || (sd == sll && (eL ^ 3) < eL));
            const bool ing = (lane < 16) && (gL == bg);
            const unsigned long long m0 = __ballot(ing && rk == 0), m1 = __ballot(ing && rk == 1);
            const int l0 = m0 ? (int)__builtin_ctzll(m0) : 0, l1 = m1 ? (int)__builtin_ctzll(m1) : 0;
            const int e0 = __builtin_amdgcn_readlane(eL, l0), e1 = __builtin_amdgcn_readlane(eL, l1);
            const float p0 = __uint_as_float((unsigned)__builtin_amdgcn_readlane((int)__float_as_uint(prl), l0)), p1 = __uint_as_float((unsigned)__builtin_amdgcn_readlane((int)__float_as_uint(prl), l1));
            const float inv = 1.0f / (p0 + p1);
            if (lane == 0) { re[2 * rl] = (unsigned)e0; re[2 * rl + 1] = (unsigned)e1; rw[2 * rl] = p0 * inv; rw[2 * rl + 1] = p1 * inv; }
        }
        __syncthreads();
        LAS unsigned* wcnt = lbase + 16; LAS unsigned* wbase = lbase + 80;
        unsigned ee = 0u, rk = 0u;
        if (wid < 4) { ee = re[tid];
#pragma unroll
            for (int x = 0; x < 16; ++x) { const unsigned long long bm = __ballot(ee == (unsigned)x);
                const unsigned below = __builtin_amdgcn_mbcnt_hi((unsigned)(bm >> 32), __builtin_amdgcn_mbcnt_lo((unsigned)bm, 0u));
                rk = (ee == (unsigned)x) ? below : rk;
                if (lane == 0) wcnt[wid * 16 + x] = (unsigned)__builtin_popcountll(bm); } }
        __syncthreads();
        if (tid < 16) { const unsigned c0 = wcnt[tid], c1 = wcnt[16 + tid], c2 = wcnt[32 + tid], c3 = wcnt[48 + tid], c = c0 + c1 + c2 + c3;
            const unsigned base = c ? __hip_atomic_fetch_add(ecnt + 64 * tid, c, RLX_AGENT) : 0u;
            wbase[tid] = base; wbase[16 + tid] = base + c0; wbase[32 + tid] = base + c0 + c1; wbase[48 + tid] = base + c0 + c1 + c2; }
        __syncthreads();
        if (wid < 4) { const unsigned pos = wbase[wid * 16 + ee] + rk; const unsigned tok = (unsigned)(chunk * 128 + (tid >> 1));
            if (pos < 32768u) { liste[(size_t)ee * 32768 + pos] = tok * 2u + (unsigned)(tid & 1); listw[(size_t)ee * 32768 + pos] = rw[tid]; } }
        __syncthreads();
    }
}
__device__ __forceinline__ void ln2_phase(Frame& F, const Args& a, int l, float* x, const bf16_t* y0, const bf16_t* y1, bf16_t* unext) {
    const int lane = F.lane_(); const int gw = F.vcu * NWAVES + F.wave, NGW = F.G * NWAVES;
    const float* modl = (const float*)(F.ws + WS_MOD) + (size_t)l * 4 * 6144;
    const float* lg = a.in[IN_LN2G] + l * D; const float* lb = a.in[IN_LN2B] + l * D;
    constexpr int RPW = 16;
    for (int chunk = gw; chunk < M / RPW; chunk += NGW) {
    const int m0 = chunk * RPW; const int b = m0 >> 13; const float* mb = modl + (size_t)b * 6144; const float* mn = mb + 4 * 6144;
    f32x4 lgv[4], lbv[4], g1[4], sc1[4], shv[4];
#pragma unroll
    for (int j = 0; j < 4; ++j) { const int c = 4 * lane + 256 * j; lgv[j] = *(const f32x4*)(lg + c); lbv[j] = *(const f32x4*)(lb + c); g1[j] = *(const f32x4*)(mb + 5 * D + c) + 1.0f;
        if (unext) { sc1[j] = *(const f32x4*)(mn + D + c) + 1.0f; shv[j] = *(const f32x4*)(mn + c); } else { sc1[j] = f32x4{}; shv[j] = f32x4{}; } }
    f32x4 xn[4]; u32x2 yan[4], ybn[4];
#pragma unroll
    for (int j = 0; j < 4; ++j) { const int c = 4 * lane + 256 * j; xn[j] = *(const f32x4*)(x + (size_t)m0 * D + c); yan[j] = *(const u32x2*)(y0 + (size_t)m0 * D + c); ybn[j] = *(const u32x2*)(y1 + (size_t)m0 * D + c); }
    for (int i = 0; i < RPW; ++i) {
        const int m = m0 + i;
        f32x4 z[4]; float s = 0.f;
#pragma unroll
        for (int j = 0; j < 4; ++j) { const f32x4 xv = xn[j];
            const u32x2 ya = yan[j], yb = ybn[j];
            const f32x4 yy = (f32x4){bflo(ya.x) + bflo(yb.x), bfhi(ya.x) + bfhi(yb.x), bflo(ya.y) + bflo(yb.y), bfhi(ya.y) + bfhi(yb.y)};
            z[j] = xv * ALPHA + g1[j] * yy; s += (z[j][0] + z[j][1]) + (z[j][2] + z[j][3]); }
        if (i + 1 < RPW) { const size_t mn_ = (size_t)(m + 1);
#pragma unroll
            for (int j = 0; j < 4; ++j) { const int c = 4 * lane + 256 * j; xn[j] = *(const f32x4*)(x + mn_ * D + c); yan[j] = *(const u32x2*)(y0 + mn_ * D + c); ybn[j] = *(const u32x2*)(y1 + mn_ * D + c); } }
        const float mean = wave_sum(s) * (1.f / D); float s2 = 0.f;
#pragma unroll
        for (int j = 0; j < 4; ++j) { z[j] = z[j] - mean; s2 += (z[j][0] * z[j][0] + z[j][1] * z[j][1]) + (z[j][2] * z[j][2] + z[j][3] * z[j][3]); }
        const float rstd = rsqrtf(wave_sum(s2) * (1.f / D) + LN_EPS);
#pragma unroll
        for (int j = 0; j < 4; ++j) { const int c = 4 * lane + 256 * j;
            const f32x4 x2 = z[j] * rstd * lgv[j] + lbv[j];
            *(f32x4*)(x + (size_t)m * D + c) = x2;
            if (unext) { const f32x4 u = x2 * sc1[j] + shv[j];
                *(u32x2*)(unext + (size_t)m * D + c) = (u32x2){cvt_pk_bf16(u[0], u[1]), cvt_pk_bf16(u[2], u[3])}; } }
    }
    }
}

#if defined(__HIP_DEVICE_COMPILE__)
#define NO_PK_F32 __attribute__((target("no-packed-fp32-ops")))
#else
#define NO_PK_F32
#endif
__global__ void __launch_bounds__(NTHREADS, 2) NO_PK_F32 fwd_kernel(Args args) {
    extern __shared__ __attribute__((aligned(16))) unsigned char lds_raw[];
    Frame F;
    F.lds = (LAS unsigned char*)lds_raw;
    F.wave = __builtin_amdgcn_readfirstlane((int)threadIdx.x >> 6);
    F.G = gridDim.x; { const int bx = blockIdx.x; F.vcu = (F.G % 8 == 0) ? (bx % 8) * (F.G / 8) + bx / 8 : bx; }
    typedef __attribute__((address_space(4))) const Args CArgs;
    CArgs* AP = (CArgs*)__builtin_amdgcn_kernarg_segment_ptr();
#define ARGS (*(const Args*)AP)
    F.ws = ARGS.ws; F.ctl = (gu32*)(F.ws + WS_CTL);
    volatile LAS unsigned* MISC = (volatile LAS unsigned*)(F.lds + LDS_MISC);
    for (int u = F.tid_(); u < (LDS_BYTES - LDS_MISC) / 4; u += NTHREADS) ((LAS unsigned*)(F.lds + LDS_MISC))[u] = 0u;
    __syncthreads();
    const int lo = ARGS.ph_lo, hi = ARGS.ph_hi;
    const bool multi = (hi - lo) > 1;
    XcdBarrier bar; bar.bar = (unsigned*)(F.ctl + CW_BAR); bar.x = 0; bar.st = nullptr;
    if (multi) bar = xcd_barrier_post((unsigned*)(F.ctl + CW_BAR), MISC + MISC_BARW);
#define IN(k) (lo <= (k) && (k) < hi && (F.ws = (unsigned char*)launder_s((GAS unsigned char*)F.ws), F.ctl = (gu32*)F.ws, F.vcu = launder_si(F.vcu), F.wave = launder_si(F.wave), F.G = launder_si(F.G), AP = launder_s(AP), true))
#define SEAM(k) do { if (IN((k) + 1)) xcd_barrier(bar); } while (0)
#define UBUF ((bf16_t*)(F.ws + WS_UBUF))
#define R1 ((bf16_t*)(F.ws + WS_R1))
#define OBUF ((bf16_t*)(F.ws + WS_OBUF))
#define mod ((const float*)(F.ws + WS_MOD))

    if (IN(0)) { p0_prologue(F, ARGS); SEAM(0); }
    for (int l = 0; l < DEPTH; ++l) {
        const int pb = 1 + PPL * l;
        const float* modl = mod + (size_t)l * 4 * 6144;
        if (l == 0 && IN(pb + 0)) { modulate_rows(F, ARGS.in[IN_X], modl, 0, 1, UBUF); SEAM(pb + 0); }
        if (IN(pb + 1)) {
            pg8::FullOrder S; S.init(UBUF, D, (const bf16_t*)(F.ws + WS_WIN) + (size_t)l * NWIN * D, D, M, NPT * 256, F.G, (int)blockIdx.x);
            pg8::EpiInproj E{R1, (bf16_t*)(F.ws + WS_IKC)};
            pg8::gemm_phase<pg8::EpiInproj, pg8::FullOrder, true, false>(F.lds + LDS_BIG, S, E, F.wave);
            SEAM(pb + 1);
        }
        if (IN(pb + 2)) { attention_phase(F, ARGS, l); SEAM(pb + 2); }
        if (IN(pb + 3)) { combine_c(F); SEAM(pb + 3); }
        if (IN(pb + 4)) {
            pg8::FullOrder S; S.init(UBUF, D, (const bf16_t*)(F.ws + WS_WIN) + ((size_t)l * NWIN + NPT * 256) * D, D, M, NGT * 256, F.G, (int)blockIdx.x);
            pg8::EpiGate E{R1};
            pg8::gemm_phase<pg8::EpiGate, pg8::FullOrder, true, false>(F.lds + LDS_BIG, S, E, F.wave);
            SEAM(pb + 4);
        }
        if (IN(pb + 5)) {
            pg8::MergeOrder S; S.fo.init(OBUF, 1024, nullptr, 256, M, D, F.G, (int)blockIdx.x); S.Wb = (const char*)((const bf16_t*)(F.ws + WS_WB) + (size_t)l * 4 * D * 256); S.K = 256; S.lda = 1024;
            pg8::EpiMerge E{R1, UBUF};
            pg8::gemm_phase<pg8::EpiMerge, pg8::MergeOrder, false, false>(F.lds + LDS_BIG, S, E, F.wave);
            SEAM(pb + 5);
        }
        if (IN(pb + 6)) {
            pg8::FullOrder S; S.init(UBUF, D, (const bf16_t*)(F.ws + WS_WO) + (size_t)l * D * D, D, M, D, F.G, (int)blockIdx.x);
            pg8::EpiPlain E{OBUF, D};
            pg8::gemm_phase<pg8::EpiPlain, pg8::FullOrder, true, false>(F.lds + LDS_BIG, S, E, F.wave);
            SEAM(pb + 6);
        }
        if (IN(pb + 7)) { ln1_phase(F, ARGS, l, l == 0 ? ARGS.in[IN_X] : ARGS.out, ARGS.out, OBUF, UBUF); SEAM(pb + 7); }
        if (IN(pb + 8)) {
            pg8::MoeOrder S; S.init(F.ctl + CW_ECNT + 1024 * l, 2, F.G, F.vcu); S.A = (const char*)UBUF; S.lda = 0; S.K = D; S.W = (const char*)((const bf16_t*)(F.ws + WS_W1) + (size_t)l * 16 * 512 * D); S.wstride = (size_t)512 * D * 2;
            S.liste = (const unsigned*)(F.ws + WS_LISTE);
            pg8::EpiMoe1 E{(bf16_t*)(F.ws + WS_R1 + R1_H)};
            pg8::gemm_phase<pg8::EpiMoe1, pg8::MoeOrder, true, true>(F.lds + LDS_BIG, S, E, F.wave);
            SEAM(pb + 8);
        }
        if (IN(pb + 9)) {
            pg8::MoeOrder S; S.init(F.ctl + CW_ECNT + 1024 * l, 4, F.G, F.vcu); S.A = (const char*)(F.ws + WS_R1 + R1_H); S.lda = 256; S.K = 256; S.W = (const char*)((const bf16_t*)(F.ws + WS_W2) + (size_t)l * 16 * D * 256); S.wstride = (size_t)D * 256 * 2;
            S.liste = (const unsigned*)(F.ws + WS_LISTE);
            pg8::EpiMoe2 E{(bf16_t*)(F.ws + WS_R1 + R1_Y0), (bf16_t*)(F.ws + WS_R1 + R1_Y1), (const unsigned*)(F.ws + WS_LISTE), (const float*)(F.ws + WS_LISTW)};
            pg8::gemm_phase<pg8::EpiMoe2, pg8::MoeOrder, true, false>(F.lds + LDS_BIG, S, E, F.wave);
            SEAM(pb + 9);
        }
        if (IN(pb + 10)) { ln2_phase(F, ARGS, l, ARGS.out, (const bf16_t*)(F.ws + WS_R1 + R1_Y0), (const bf16_t*)(F.ws + WS_R1 + R1_Y1), (l + 1 < DEPTH) ? UBUF : nullptr); if (pb + 10 + 1 < N_PHASES) SEAM(pb + 10); }
    }
#undef IN
#undef SEAM
#undef ARGS
#undef UBUF
#undef R1
#undef OBUF
#undef mod
}

#if DBG
__device__ __forceinline__ void rms_acc(unsigned* errw, int id, float got, float ref) { atomicAdd((float*)errw + 64 + 2 * id, (got - ref) * (got - ref)); atomicAdd((float*)errw + 65 + 2 * id, ref * ref); }
__device__ __forceinline__ void err_max(unsigned* errw, int id, float e) { if (!(e == e)) e = 1e30f; if (e < 0.f) e = 0.f; atomicMax(errw + id, __float_as_uint(e)); }
__device__ __forceinline__ unsigned hash_u32(unsigned x) { x ^= x >> 16; x *= 0x7feb352du; x ^= x >> 15; x *= 0x846ca68bu; x ^= x >> 16; return x; }
__device__ __forceinline__ void inproj_loc(int j, int& pn, int& c, float& sc, int& lg) {
    sc = 1.f; lg = 0;
    if (j < 256) { pn = T_AQ; c = j; sc = SC32; }
    else if (j < 512) { pn = T_AK; c = j - 256; }
    else if (j < 768) { pn = T_AV; c = j - 512; }
    else if (j < 1024) { pn = T_BQ; c = j - 768; sc = SC64; }
    else if (j < 1152) { pn = T_BKV; c = j - 1024; }
    else if (j < 1280) { pn = T_BKV; c = 128 + j - 1152; }
    else if (j < 2048) { const int g = (j - 1280) / 256; pn = T_CQ + g; c = (j - 1280) % 256; sc = SC64; lg = 2 * g; }
    else if (j < 2816) { const int g = (j - 2048) / 256; pn = T_CK + g; c = (j - 2048) % 256; lg = 2 * g; }
    else if (j < 3584) { const int g = (j - 2816) / 256; pn = T_CV + g; c = (j - 2816) % 256; lg = 2 * g; }
    else if (j < 3840) { pn = T_DQ; c = j - 3584; sc = SC64; }
    else if (j < 3904) { pn = T_MISC; c = j - 3840; }
    else if (j < 3968) { pn = T_MISC; c = 64 + j - 3904; }
    else if (j < 4224) { pn = T_IQ; c = j - 3968; }
    else if (j < 4256) { pn = T_MISC; c = 128 + j - 4224; }
    else if (j < 4264) { pn = T_MISC; c = 160 + j - 4256; }
    else { pn = (j - 4264) / 256; c = (j - 4264) % 256; }
}
__global__ void chk_mod(Args a, int l) {
    unsigned* errw = (unsigned*)(a.ws + WS_CTL) + CW_ERR;
    const int s = blockIdx.x * blockDim.x + threadIdx.x; if (s >= 512) return;
    const unsigned h = hash_u32(s * 7919u + 13u + l); const int b = h & 3, j = (h >> 2) % 6144;
    float r = a.in[IN_BADA][(size_t)l * 6144 + j];
    for (int k = 0; k < D; ++k) { const float cv = a.in[IN_C][b * D + k]; r += (cv / (1.f + expf(-cv))) * a.in[IN_WADA][((size_t)l * D + k) * 6144 + j]; }
    const float got = ((const float*)(a.ws + WS_MOD))[((size_t)l * 4 + b) * 6144 + j];
    err_max(errw, 11, fabsf(got - r) / (1e-4f + 1e-3f * fabsf(r)));
}
__global__ void chk_u(Args a, int l, const float* xin) {
    unsigned* errw = (unsigned*)(a.ws + WS_CTL) + CW_ERR;
    const int s = blockIdx.x * blockDim.x + threadIdx.x; if (s >= 4096) return;
    const unsigned h = hash_u32(s * 7919u + 17u); const int m = h % M, c = (h >> 15) % D, b = m >> 13;
    const float* modl = (const float*)(a.ws + WS_MOD) + ((size_t)l * 4 + b) * 6144;
    const float r = xin[(size_t)m * D + c] * (1.f + modl[D + c]) + modl[c];
    const float got = bf2f(((const bf16_t*)(a.ws + WS_UBUF))[(size_t)m * D + c]);
    err_max(errw, 12, fabsf(got - r) / (0.01f + 0.01f * fabsf(r)));
}
__global__ void chk_inproj(Args a, int l, int gates) {
    unsigned* errw = (unsigned*)(a.ws + WS_CTL) + CW_ERR;
    const int s = blockIdx.x * (blockDim.x >> 6) + (threadIdx.x >> 6), lane = threadIdx.x & 63; if (s >= 2048) return;
    const unsigned h = hash_u32(s * 104729u + 31u + gates); const int m = h % M; const int j = gates ? 4264 + (int)((h >> 15) % 4096) : (int)((h >> 15) % 4264);
    const bf16_t* u = (const bf16_t*)(a.ws + WS_UBUF) + (size_t)m * D; const float* w = a.in[IN_WIN] + (size_t)l * D * INW + j;
    float r = 0.f; for (int k = lane; k < D; k += 64) r += bf2f(u[k]) * w[(size_t)k * INW];
    r = wave_sum(r);
    int pn, c, lg; float sc; inproj_loc(j, pn, c, sc, lg);
    const int prow = pg8::perm_row(m, lg);
    float got = bf2f(((const bf16_t*)(a.ws + WS_R1))[(size_t)pn * TILE_E + (size_t)prow * 256 + c]);
    if (gates) r = 1.f / (1.f + expf(-r)); else got /= sc;
    if (lane == 0) { rms_acc(errw, gates ? 20 : 13, got, r); err_max(errw, gates ? 20 : 13, fabsf(got - r) / (0.03f + 0.02f * fabsf(r))); }
}

__device__ __forceinline__ float bias2(const float* rel, int dist, int head) { return rel[t5_bucket(dist) * NBH + head] * LOG2E; }
template <int type> __global__ void __launch_bounds__(64) chk_attn_ab(Args a, int l) {
    unsigned* errw = (unsigned*)(a.ws + WS_CTL) + CW_ERR;
    const bf16_t* R1 = (const bf16_t*)(a.ws + WS_R1); const bf16_t* OB = (const bf16_t*)(a.ws + WS_OBUF);
    const int lane = threadIdx.x; const unsigned hs = hash_u32(blockIdx.x * 2654435761u + 77u + type);
    const int b = hs & 3, h = (hs >> 2) & 3; int t = (hs >> 4) & (SEQ - 1); if (blockIdx.x < 4) t = blockIdx.x * 37; if (blockIdx.x == 4) t = SEQ - 1;
    const long row = (long)b * SEQ + t; const float* rel = a.in[IN_REL];
    constexpr int nmap = type == 0 ? 2 : 1, qd = type == 0 ? 32 : 64;
    const bf16_t* qp = R1 + (size_t)(type == 0 ? T_AQ : T_BQ) * TILE_E + row * 256 + h * 64;
    const bf16_t* kb = type == 0 ? R1 + (size_t)T_AK * TILE_E + h * 64 : R1 + (size_t)T_BKV * TILE_E + (h >> 1) * 64;
    const bf16_t* vbp = type == 0 ? R1 + (size_t)T_AV * TILE_E + h * 64 : R1 + (size_t)T_BKV * TILE_E + 128 + (h >> 1) * 64;
    float q[64];
#pragma unroll
    for (int d = 0; d < 64; ++d) q[d] = bf2f(qp[d]);
    const int klo = type == 0 ? 0 : (t - 127 > 0 ? t - 127 : 0);
    float mx[2] = {-1e30f, -1e30f};
    for (int k = klo + lane; k <= t; k += 64) { const bf16_t* kr = kb + ((long)b * SEQ + k) * 256; const float bs = bias2(rel, t - k, (type == 0 ? 0 : 4) + h);
        _Pragma("unroll") for (int m = 0; m < nmap; ++m) { float s = 0.f; _Pragma("unroll") for (int d = 0; d < qd; ++d) s += q[m * 32 + d] * bf2f(kr[m * 32 + d]); s += bs; mx[m] = fmaxf(mx[m], s); } }
    for (int m = 0; m < 2; ++m) for (int o = 1; o < 64; o <<= 1) mx[m] = fmaxf(mx[m], __shfl_xor(mx[m], o));
    float ls[2] = {0.f, 0.f}; float acc[2][64];
#pragma unroll
    for (int m = 0; m < 2; ++m)
#pragma unroll
        for (int d = 0; d < 64; ++d) acc[m][d] = 0.f;
    for (int k = klo + lane; k <= t; k += 64) { const bf16_t* kr = kb + ((long)b * SEQ + k) * 256; const bf16_t* vr = vbp + ((long)b * SEQ + k) * 256; const float bs = bias2(rel, t - k, (type == 0 ? 0 : 4) + h);
        float p[2] = {0.f, 0.f};
        _Pragma("unroll") for (int m = 0; m < nmap; ++m) { float s = 0.f; _Pragma("unroll") for (int d = 0; d < qd; ++d) s += q[m * 32 + d] * bf2f(kr[m * 32 + d]); s += bs; p[m] = exp2f(s - mx[m]); ls[m] += p[m]; }
        _Pragma("unroll") for (int d = 0; d < 64; ++d) { const float v = bf2f(vr[d]); acc[0][d] += p[0] * v; if (nmap == 2) acc[1][d] += p[1] * v; } }
    for (int m = 0; m < 2; ++m) ls[m] = wave_sum(ls[m]);
    float mine = 0.f;
#pragma unroll
    for (int d = 0; d < 64; ++d) { const float a0 = wave_sum(acc[0][d]), a1 = nmap == 2 ? wave_sum(acc[1][d]) : 0.f; float v;
        if (type == 0) v = a0 / ls[0] - ((const float*)(a.ws + WS_LAM))[l] * a1 / ls[1]; else v = a0 / (ls[0] + exp2f(a.in[IN_SINKS][l * 4 + h] * LOG2E - mx[0]));
        if (d == lane) mine = v; }
    if (type == 0) { const float ss = wave_sum(mine * mine); mine = mine * rsqrtf(ss / 64.f + 1e-5f) * a.in[IN_SUBLN][l * 64 + lane] * (1.f - ((const float*)(a.ws + WS_LAM))[2 + l]); }
    const float got = bf2f(OB[row * 1024 + (type == 0 ? 0 : 256) + h * 64 + lane]);
    float e = fabsf(got - mine) / (0.02f + 0.03f * fabsf(mine));
    rms_acc(errw, type == 0 ? 14 : 15, got, mine);
    for (int o = 1; o < 64; o <<= 1) e = fmaxf(e, __shfl_xor(e, o));
    if (lane == 0) err_max(errw, type == 0 ? 14 : 15, e);
}
__global__ void __launch_bounds__(64) chk_attn_c(Args a, int l) {
    unsigned* errw = (unsigned*)(a.ws + WS_CTL) + CW_ERR;
    const bf16_t* R1 = (const bf16_t*)(a.ws + WS_R1);
    const int lane = threadIdx.x; const unsigned hs = hash_u32(blockIdx.x * 2654435761u + 991u);
    const int b = hs & 3, h = (hs >> 2) & 3, g = (hs >> 4) % 3; int t = (hs >> 8) & (SEQ - 1); if (blockIdx.x < 6) t = blockIdx.x * 53;
    const int lg = 2 * g, r = 1 << lg; const long row = (long)b * SEQ + t; const float* rel = a.in[IN_REL];
    float qv = 0.f; { const bf16_t* u = (const bf16_t*)(a.ws + WS_UBUF) + row * D; const float* w = a.in[IN_WIN] + (size_t)l * D * INW + 1280 + g * 256 + h * 64 + lane;
        for (int k = 0; k < D; ++k) qv += bf2f(u[k]) * w[(size_t)k * INW]; qv = bf2f(f2bf(qv * SC64)); }
    float q[64]; _Pragma("unroll") for (int d = 0; d < 64; ++d) q[d] = __shfl(qv, d);
    const bf16_t* kb = R1 + (size_t)(T_CK + g) * TILE_E + h * 64; const bf16_t* vbp = R1 + (size_t)(T_CV + g) * TILE_E + h * 64;
    float mx = -1e30f;
    for (int j = lane; j <= 128; j += 64) { const int kt = t - r * j; if (kt < 0) continue; const bf16_t* kr = kb + (long)pg8::perm_row((int)((long)b * SEQ + kt), lg) * 256;
        float s = 0.f; _Pragma("unroll") for (int d = 0; d < 64; ++d) s += q[d] * bf2f(kr[d]); s += bias2(rel, r * j, 8 + 4 * g + h); mx = fmaxf(mx, s); }
    for (int o = 1; o < 64; o <<= 1) mx = fmaxf(mx, __shfl_xor(mx, o));
    float ls = 0.f; float acc[64]; _Pragma("unroll") for (int d = 0; d < 64; ++d) acc[d] = 0.f;
    for (int j = lane; j <= 128; j += 64) { const int kt = t - r * j; if (kt < 0) continue; const long pr = pg8::perm_row((int)((long)b * SEQ + kt), lg); const bf16_t* kr = kb + pr * 256; const bf16_t* vr = vbp + pr * 256;
        float s = 0.f; _Pragma("unroll") for (int d = 0; d < 64; ++d) s += q[d] * bf2f(kr[d]); s += bias2(rel, r * j, 8 + 4 * g + h); const float p = exp2f(s - mx); ls += p;
        _Pragma("unroll") for (int d = 0; d < 64; ++d) acc[d] += p * bf2f(vr[d]); }
    ls = wave_sum(ls); float mine = 0.f;
    _Pragma("unroll") for (int d = 0; d < 64; ++d) { const float a0 = wave_sum(acc[d]); if (d == lane) mine = a0 / ls; }
    const long prow = pg8::perm_row((int)row, lg);
    const float got = bf2f(R1[(size_t)(T_CQ + g) * TILE_E + prow * 256 + h * 64 + lane]);
    float e = fabsf(got - mine) / (0.02f + 0.03f * fabsf(mine));
    rms_acc(errw, 16, got, mine);
    const float lse = mx + log2f(ls), glse = ((const float*)(a.ws + WS_LSE))[((size_t)g * M + prow) * 4 + h];
    e = fmaxf(e, fabsf(lse - glse) / 0.05f);
    for (int o = 1; o < 64; o <<= 1) e = fmaxf(e, __shfl_xor(e, o));
    if (lane == 0) err_max(errw, 16, e);
}
__global__ void __launch_bounds__(256) chk_attn_d(Args a, int l, float* scratch) {
    unsigned* errw = (unsigned*)(a.ws + WS_CTL) + CW_ERR;
    const bf16_t* R1 = (const bf16_t*)(a.ws + WS_R1); const bf16_t* OB = (const bf16_t*)(a.ws + WS_OBUF);
    const bf16_t* misc = R1 + (size_t)T_MISC * TILE_E;
    const int tid = threadIdx.x; const unsigned hs = hash_u32(blockIdx.x * 2654435761u + 4242u);
    const int b = hs & 3; int t = (hs >> 2) & (SEQ - 1); if (blockIdx.x < 8) t = blockIdx.x * 97 + (blockIdx.x == 7 ? 7000 : 0); if (blockIdx.x == 8) t = 255; if (blockIdx.x == 9) t = 256; if (blockIdx.x == 10) t = SEQ - 1;
    const long row = (long)b * SEQ + t; const float* rel = a.in[IN_REL];
    unsigned* keys = (unsigned*)scratch + (size_t)blockIdx.x * SEQ;
    __shared__ float iq[256]; __shared__ float iw[8]; __shared__ unsigned cnt; __shared__ int selidx[256]; __shared__ float pl[4][256]; __shared__ float red[256];
    iq[tid] = bf2f(R1[(size_t)T_IQ * TILE_E + row * 256 + tid]); if (tid < 8) iw[tid] = bf2f(misc[row * 256 + 160 + tid]);
    __syncthreads();
    for (int k = tid; k <= t; k += 256) { const bf16_t* kr = misc + ((long)b * SEQ + k) * 256 + 128; float sc = 0.f;
        for (int h = 0; h < 8; ++h) { float s = 0.f; for (int d = 0; d < 32; ++d) s += iq[h * 32 + d] * bf2f(kr[d]); sc += fmaxf(s, 0.f) * iw[h]; }
        keys[k] = dsel::okey(sc); }
    __syncthreads();
    const int n = t + 1, ksel = n < 256 ? n : 256;
    unsigned T = 0u;
    if (n > 256) { for (int bit = 31; bit >= 0; --bit) { const unsigned cand = T | (1u << bit); if (tid == 0) cnt = 0u; __syncthreads();
            unsigned c = 0; for (int k = tid; k < n; k += 256) c += keys[k] >= cand ? 1u : 0u; atomicAdd(&cnt, c); __syncthreads();
            if (cnt >= 256u) T = cand; __syncthreads(); } }
    if (tid == 0) { int p = 0; int gt = 0; for (int k = 0; k < n; ++k) if (n <= 256 || keys[k] > T) { selidx[p++] = k; ++gt; }
        if (n > 256) for (int k = 0; k < n && p < 256; ++k) if (keys[k] == T) selidx[p++] = k; }
    __syncthreads();
    const bf16_t* dq = R1 + (size_t)T_DQ * TILE_E + row * 256;
    float lg4[4] = {-1e30f, -1e30f, -1e30f, -1e30f};
    if (tid < ksel) { const int k = selidx[tid]; const bf16_t* kr = misc + ((long)b * SEQ + k) * 256;
        for (int h = 0; h < 4; ++h) { float s = 0.f; for (int d = 0; d < 64; ++d) s += bf2f(dq[h * 64 + d]) * bf2f(kr[d]); lg4[h] = s + bias2(rel, t - k, 20 + h); } }
    float den[4];
    for (int h = 0; h < 4; ++h) { red[tid] = lg4[h]; __syncthreads(); for (int o = 128; o > 0; o >>= 1) { if (tid < o) red[tid] = fmaxf(red[tid], red[tid + o]); __syncthreads(); } const float mxv = red[0]; __syncthreads();
        const float p = tid < ksel ? exp2f(lg4[h] - mxv) : 0.f; pl[h][tid] = p; red[tid] = p; __syncthreads(); for (int o = 128; o > 0; o >>= 1) { if (tid < o) red[tid] += red[tid + o]; __syncthreads(); } den[h] = red[0]; __syncthreads(); }
    const int h = tid >> 6, d = tid & 63; float o = 0.f;
    for (int i = 0; i < ksel; ++i) o += pl[h][i] * bf2f(misc[((long)b * SEQ + selidx[i]) * 256 + 64 + d]);
    o /= den[h];
    const float got = bf2f(OB[row * 1024 + 768 + h * 64 + d]);
    rms_acc(errw, 17, got, o);
    red[tid] = (got - o) * (got - o); __syncthreads(); for (int s = 128; s > 0; s >>= 1) { if (tid < s) red[tid] += red[tid + s]; __syncthreads(); } const float num = red[0]; __syncthreads();
    red[tid] = o * o; __syncthreads(); for (int s = 128; s > 0; s >>= 1) { if (tid < s) red[tid] += red[tid + s]; __syncthreads(); }
    if (tid == 0) err_max(errw, 17, sqrtf(num) / (sqrtf(red[0]) + 0.02f) / 0.05f);
}

__global__ void chk_combine(Args a) {
    unsigned* errw = (unsigned*)(a.ws + WS_CTL) + CW_ERR; const bf16_t* R1 = (const bf16_t*)(a.ws + WS_R1);
    const int s = blockIdx.x * blockDim.x + threadIdx.x; if (s >= 4096) return;
    const unsigned hs = hash_u32(s * 7919u + 555u); const int m = hs % M, c = (hs >> 15) & 255, h = c >> 6;
    float ls[3], ov[3]; for (int g = 0; g < 3; ++g) { const size_t pr = (size_t)pg8::perm_row(m, 2 * g); ls[g] = ((const float*)(a.ws + WS_LSE))[((size_t)g * M + pr) * 4 + h]; ov[g] = bf2f(R1[(size_t)(T_CQ + g) * TILE_E + pr * 256 + c]); }
    const float mx = fmaxf(fmaxf(ls[0], ls[1]), ls[2]); float ws = 0.f, o = 0.f; for (int g = 0; g < 3; ++g) { const float w = exp2f(ls[g] - mx); ws += w; o += w * ov[g]; } o /= ws;
    const float got = bf2f(((const bf16_t*)(a.ws + WS_OBUF))[(size_t)m * 1024 + 512 + c]);
    rms_acc(errw, 21, got, o); err_max(errw, 21, fabsf(got - o) / (0.01f + 0.02f * fabsf(o)));
}
__global__ void chk_merge(Args a, int l) {
    unsigned* errw = (unsigned*)(a.ws + WS_CTL) + CW_ERR; const bf16_t* R1 = (const bf16_t*)(a.ws + WS_R1); const bf16_t* OB = (const bf16_t*)(a.ws + WS_OBUF);
    const int s = blockIdx.x * (blockDim.x >> 6) + (threadIdx.x >> 6), lane = threadIdx.x & 63; if (s >= 1024) return;
    const unsigned hs = hash_u32(s * 104729u + 999u); const int m = hs % M, c = (hs >> 15) & 1023;
    float r = 0.f;
    for (int i = 0; i < 4; ++i) { float p = 0.f; for (int k = lane; k < 256; k += 64) p += bf2f(OB[(size_t)m * 1024 + i * 256 + k]) * a.in[IN_WBRANCH][(((size_t)l * 4 + i) * 256 + k) * D + c];
        p = wave_sum(p); r += bf2f(R1[(size_t)(i * 4 + (c >> 8)) * TILE_E + (size_t)m * 256 + (c & 255)]) * p; }
    const float got = bf2f(((const bf16_t*)(a.ws + WS_UBUF))[(size_t)m * D + c]);
    if (lane == 0) { rms_acc(errw, 22, got, r); err_max(errw, 22, fabsf(got - r) / (0.03f + 0.03f * fabsf(r))); }
}
__global__ void chk_outproj(Args a, int l) {
    unsigned* errw = (unsigned*)(a.ws + WS_CTL) + CW_ERR;
    const int s = blockIdx.x * (blockDim.x >> 6) + (threadIdx.x >> 6), lane = threadIdx.x & 63; if (s >= 1024) return;
    const unsigned hs = hash_u32(s * 104729u + 1234u); const int m = hs % M, c = (hs >> 15) & 1023;
    float r = 0.f; for (int k = lane; k < D; k += 64) r += bf2f(((const bf16_t*)(a.ws + WS_UBUF))[(size_t)m * D + k]) * a.in[IN_WOUT][((size_t)l * D + k) * D + c];
    r = wave_sum(r);
    const float got = bf2f(((const bf16_t*)(a.ws + WS_OBUF))[(size_t)m * D + c]);
    if (lane == 0) { rms_acc(errw, 23, got, r); err_max(errw, 23, fabsf(got - r) / (0.02f + 0.02f * fabsf(r))); }
}
__global__ void __launch_bounds__(64) chk_ln1(Args a, int l, const float* xin) {
    unsigned* errw = (unsigned*)(a.ws + WS_CTL) + CW_ERR;
    const int lane = threadIdx.x; const unsigned hs = hash_u32(blockIdx.x * 2654435761u + 31337u); const int m = hs % M, b = m >> 13;
    const float* mb = (const float*)(a.ws + WS_MOD) + ((size_t)l * 4 + b) * 6144;
    float z[16]; float s = 0.f;
    _Pragma("unroll") for (int j = 0; j < 16; ++j) { const int c = lane + 64 * j; z[j] = ALPHA * xin[(size_t)m * D + c] + (1.f + mb[2 * D + c]) * bf2f(((const bf16_t*)(a.ws + WS_OBUF))[(size_t)m * D + c]); s += z[j]; }
    const float mean = wave_sum(s) / D; float s2 = 0.f; _Pragma("unroll") for (int j = 0; j < 16; ++j) { z[j] -= mean; s2 += z[j] * z[j]; }
    const float rstd = rsqrtf(wave_sum(s2) / D + LN_EPS);
    float e = 0.f; float lg[16]; _Pragma("unroll") for (int k = 0; k < 16; ++k) lg[k] = 0.f;
    _Pragma("unroll") for (int j = 0; j < 16; ++j) { const int c = lane + 64 * j; const float x1 = z[j] * rstd * a.in[IN_LN1G][l * D + c] + a.in[IN_LN1B][l * D + c]; const float v = x1 * (1.f + mb[4 * D + c]) + mb[3 * D + c];
        e = fmaxf(e, fabsf(a.out[(size_t)m * D + c] - x1) / (1e-3f + 1e-3f * fabsf(x1)));
        e = fmaxf(e, fabsf(bf2f(((const bf16_t*)(a.ws + WS_UBUF))[(size_t)m * D + c]) - v) / (0.01f + 0.01f * fabsf(v)));
        _Pragma("unroll") for (int k = 0; k < 16; ++k) lg[k] += v * a.in[IN_WROUTER][c * 16 + k]; }
    for (int o = 1; o < 64; o <<= 1) e = fmaxf(e, __shfl_xor(e, o));
    if (lane == 0) err_max(errw, 24, e);
    float mx = -1e30f; _Pragma("unroll") for (int k = 0; k < 16; ++k) { lg[k] = wave_sum(lg[k]); mx = fmaxf(mx, lg[k]); }
    float pr[16], sl[16], ps = 0.f; _Pragma("unroll") for (int k = 0; k < 16; ++k) { pr[k] = expf(lg[k] - mx); ps += pr[k]; } _Pragma("unroll") for (int k = 0; k < 16; ++k) { pr[k] /= ps; sl[k] = pr[k] + a.in[IN_BROUTER][k]; }
    int bg = 0; float bgs = -1e30f; float gap = 1e30f;
    _Pragma("unroll") for (int g = 0; g < 4; ++g) { float t4[4]; _Pragma("unroll") for (int k = 0; k < 4; ++k) t4[k] = sl[4 * g + k]; for (int i = 0; i < 3; ++i) for (int k = 0; k < 3 - i; ++k) if (t4[k] < t4[k + 1]) { const float t = t4[k]; t4[k] = t4[k + 1]; t4[k + 1] = t; }
        const float gs = t4[0] + t4[1]; if (gs > bgs) { gap = gs - bgs; bgs = gs; bg = g; } else gap = fminf(gap, bgs - gs); }
    int e0 = -1, e1 = -1; _Pragma("unroll") for (int k = 0; k < 4; ++k) { const int ee = 4 * bg + k; if (e0 < 0 || sl[ee] > sl[e0]) { e1 = e0; e0 = ee; } else if (e1 < 0 || sl[ee] > sl[e1]) e1 = ee; }
    const float w0 = pr[e0] / (pr[e0] + pr[e1]);
    const unsigned* liste = (const unsigned*)(a.ws + WS_LISTE); const float* listw = (const float*)(a.ws + WS_LISTW); const unsigned* ctl = (const unsigned*)(a.ws + WS_CTL);
    float found = 0.f;
    for (int which = 0; which < 2; ++which) { const int ee = which ? e1 : e0; const unsigned n = ctl[CW_ECNT + 1024 * l + 64 * ee]; bool f = false; float wv = 0.f;
        for (unsigned i = lane; i < n && i < 32768u; i += 64) if ((liste[(size_t)ee * 32768 + i] >> 1) == (unsigned)m) { f = true; wv = listw[(size_t)ee * 32768 + i]; }
        const unsigned long long bm = __ballot(f); if (bm) { const int src = (int)__builtin_ctzll(bm); wv = __shfl(wv, src); const float want = which ? 1.f - w0 : w0; if (fabsf(wv - want) < 0.01f) found += 1.f; } }
    if (lane == 0 && gap > 0.02f) err_max(errw, 28, found >= 1.5f ? 0.f : 100.f);
}
__global__ void chk_moe(Args a, int l) {
    unsigned* errw = (unsigned*)(a.ws + WS_CTL) + CW_ERR; const unsigned* ctl = (const unsigned*)(a.ws + WS_CTL);
    const int s = blockIdx.x * (blockDim.x >> 6) + (threadIdx.x >> 6), lane = threadIdx.x & 63; if (s >= 512) return;
    const unsigned hs = hash_u32(s * 104729u + 4321u); const int e = hs & 15;
    int pre = 0, ce = 0; for (int k = 0; k < 16; ++k) { int c = (int)ctl[CW_ECNT + 1024 * l + 64 * k]; c = c > 32768 ? 32768 : c; if (k < e) pre += (c + 255) >> 8; if (k == e) ce = c; }
    if (ce == 0) return;
    int slot = (int)((hs >> 4) % (unsigned)ce); if (s < 16) slot = ce - 1;
    const unsigned ent = ((const unsigned*)(a.ws + WS_LISTE))[(size_t)e * 32768 + slot]; const int tok = ent >> 1; const float wgt = ((const float*)(a.ws + WS_LISTW))[(size_t)e * 32768 + slot];
    const bf16_t* v = (const bf16_t*)(a.ws + WS_UBUF) + (size_t)tok * D; const bf16_t* H = (const bf16_t*)(a.ws + WS_R1 + R1_H) + ((size_t)pre * 256 + slot) * 256;
    const int col = (hs >> 20) & 255;
    float g = 0.f, u = 0.f; for (int k = lane; k < D; k += 64) { const float vv = bf2f(v[k]); g += vv * a.in[IN_WEG][(((size_t)l * 16 + e) * D + k) * FFE + col]; u += vv * a.in[IN_WEU][(((size_t)l * 16 + e) * D + k) * FFE + col]; }
    g = wave_sum(g); u = wave_sum(u); const float hr = g / (1.f + expf(-g)) * u;
    if (lane == 0) { rms_acc(errw, 25, bf2f(H[col]), hr); err_max(errw, 25, fabsf(bf2f(H[col]) - hr) / (0.03f + 0.03f * fabsf(hr))); }
    const int oc = (hs >> 12) & 1023; float y = 0.f; for (int j = lane; j < FFE; j += 64) y += bf2f(H[j]) * a.in[IN_WED][(((size_t)l * 16 + e) * FFE + j) * D + oc];
    y = wave_sum(y) * wgt;
    const bf16_t* Y = (const bf16_t*)(a.ws + WS_R1 + ((ent & 1u) ? R1_Y1 : R1_Y0));
    if (lane == 0) { rms_acc(errw, 26, bf2f(Y[(size_t)tok * D + oc]), y); err_max(errw, 26, fabsf(bf2f(Y[(size_t)tok * D + oc]) - y) / (0.02f + 0.03f * fabsf(y))); }
}

__global__ void chk_lists_zero(unsigned* cnt) { const int i = blockIdx.x * blockDim.x + threadIdx.x; if (i < M) cnt[i] = 0u; }
__global__ void chk_lists_fill(Args a, int l, unsigned* cnt) {
    const unsigned* ctl = (const unsigned*)(a.ws + WS_CTL); const int e = blockIdx.y; const unsigned n = ctl[CW_ECNT + 1024 * l + 64 * e];
    for (unsigned i = blockIdx.x * blockDim.x + threadIdx.x; i < n && i < 32768u; i += gridDim.x * blockDim.x) { const unsigned ent = ((const unsigned*)(a.ws + WS_LISTE))[(size_t)e * 32768 + i]; if ((ent >> 1) < (unsigned)M) atomicAdd(cnt + (ent >> 1), (ent & 1u) ? 256u : 1u); else atomicAdd((unsigned*)(a.ws + WS_CTL) + CW_ERR + 29, 0x7f000000u); }
}
__global__ void chk_lists_verify(Args a, const unsigned* cnt) { unsigned* errw = (unsigned*)(a.ws + WS_CTL) + CW_ERR; const int i = blockIdx.x * blockDim.x + threadIdx.x; if (i < M && cnt[i] != 257u) err_max(errw, 29, 100.f); }
__global__ void __launch_bounds__(64) ln2_save(Args a, float* save) { const unsigned hs = hash_u32(blockIdx.x * 2654435761u + 60606u); const int m = hs % M; for (int c = threadIdx.x; c < D; c += 64) save[(size_t)blockIdx.x * D + c] = a.out[(size_t)m * D + c]; }
__global__ void __launch_bounds__(64) chk_ln2(Args a, int l, const float* save) {
    unsigned* errw = (unsigned*)(a.ws + WS_CTL) + CW_ERR;
    const int lane = threadIdx.x; const unsigned hs = hash_u32(blockIdx.x * 2654435761u + 60606u); const int m = hs % M, b = m >> 13;
    const float* mb = (const float*)(a.ws + WS_MOD) + ((size_t)l * 4 + b) * 6144;
    const bf16_t* y0 = (const bf16_t*)(a.ws + WS_R1 + R1_Y0); const bf16_t* y1 = (const bf16_t*)(a.ws + WS_R1 + R1_Y1);
    float z[16]; float s = 0.f;
#pragma unroll
    for (int j = 0; j < 16; ++j) { const int c = lane + 64 * j; z[j] = ALPHA * save[(size_t)blockIdx.x * D + c] + (1.f + mb[5 * D + c]) * (bf2f(y0[(size_t)m * D + c]) + bf2f(y1[(size_t)m * D + c])); s += z[j]; }
    const float mean = wave_sum(s) / D; float s2 = 0.f;
#pragma unroll
    for (int j = 0; j < 16; ++j) { z[j] -= mean; s2 += z[j] * z[j]; }
    const float rstd = rsqrtf(wave_sum(s2) / D + LN_EPS); float e = 0.f;
#pragma unroll
    for (int j = 0; j < 16; ++j) { const int c = lane + 64 * j; const float x2 = z[j] * rstd * a.in[IN_LN2G][l * D + c] + a.in[IN_LN2B][l * D + c];
        e = fmaxf(e, fabsf(a.out[(size_t)m * D + c] - x2) / (1e-3f + 1e-3f * fabsf(x2)));
        if (l + 1 < DEPTH) { const float* mn = mb + 4 * 6144; const float u = x2 * (1.f + mn[D + c]) + mn[c]; e = fmaxf(e, fabsf(bf2f(((const bf16_t*)(a.ws + WS_UBUF))[(size_t)m * D + c]) - u) / (0.01f + 0.01f * fabsf(u))); } }
    for (int o = 1; o < 64; o <<= 1) e = fmaxf(e, __shfl_xor(e, o));
    if (lane == 0) err_max(errw, 27, e);
}
__global__ void report(Args a, int complete) {
    const unsigned* errw = (const unsigned*)(a.ws + WS_CTL) + CW_ERR;
    __shared__ float val, val2; __shared__ int doit;
    if (threadIdx.x == 0) {
        doit = 0; val = 0.f; val2 = 0.f;
        const unsigned* ctl = (const unsigned*)(a.ws + WS_CTL);
        int id = 0; float e = 0.f;
        for (int i = 10; i < 64; ++i) { const float ei = __uint_as_float(errw[i]); if (ei > 1.0f) { id = i; e = ei; break; } }
        if (ctl[CW_TMO] != 0u || ctl[CW_BAR + XB_TMO] != 0u) { id = 99; e = 1.f; }
#ifdef PROBE_A
        { const float* ef = (const float*)errw + 64; const float ra = sqrtf(ef[2 * PROBE_A] / (ef[2 * PROBE_A + 1] + 1e-30f)), rb = sqrtf(ef[2 * PROBE_B] / (ef[2 * PROBE_B + 1] + 1e-30f));
          doit = 1; val = sqrtf(1e7f * fmaxf(ra, 1e-4f)); val2 = 1e7f * fmaxf(rb, 1e-4f); id = 0; }
#endif
        if (doit) {} else if (id) { int cls = 0; float t = e; while (t > 10.f && cls < 6) { t *= 0.1f; ++cls; } doit = 1; val = sqrtf((float)id * powf(10.f, 2.f + cls)); }
        else if (!complete) { doit = 1; val = sqrtf(10.f * 100.f); }
    }
    __syncthreads();
    if (doit && val2 != 0.f && blockIdx.x == 0 && threadIdx.x == 0) a.out[7] = val2;
    if (doit) { const float v = val; for (size_t i = (size_t)blockIdx.x * blockDim.x + threadIdx.x; i < (size_t)M * D; i += (size_t)gridDim.x * blockDim.x) if (!(i == 7 && val2 != 0.f)) a.out[i] = v; }
}
#endif

extern "C" void kernel_launch(void* const* d_in, const int* in_sizes, int n_in, void* d_out, int out_size, void* d_ws, size_t ws_size, hipStream_t stream) {
    static int grid = 0;
    if (grid == 0) {
        if (n_in != 21 || out_size != M * D || ws_size < WS_END) { fprintf(stderr, "kernel_launch: unexpected shapes (n_in %d out %d ws %zu)\n", n_in, out_size, ws_size); grid = -1; return; }
        int dev = 0, cus = 0, per_cu = 0;
        if (hipGetDevice(&dev) != hipSuccess || hipDeviceGetAttribute(&cus, hipDeviceAttributeMultiprocessorCount, dev) != hipSuccess) { grid = -1; return; }
        if (hipFuncSetAttribute((const void*)fwd_kernel, hipFuncAttributeMaxDynamicSharedMemorySize, LDS_BYTES) != hipSuccess) { fprintf(stderr, "kernel_launch: hipFuncSetAttribute failed\n"); grid = -1; return; }
        if (hipOccupancyMaxActiveBlocksPerMultiprocessor(&per_cu, (const void*)fwd_kernel, NTHREADS, LDS_BYTES) != hipSuccess || per_cu < 1) { fprintf(stderr, "kernel_launch: occupancy query says %d\n", per_cu); }
        (void)hipGetLastError();
        grid = cus;
    }
    if (grid < 0) return;
    (void)hipMemsetAsync((char*)d_ws + WS_CTL, 0, CTL_ZERO_BYTES, stream);
    Args a{};
    for (int i = 0; i < 21; ++i) a.in[i] = (const float*)d_in[i];
    a.out = (float*)d_out; a.ws = (unsigned char*)d_ws;
#if DBG
    for (int p = 0; p < N_PHASES; ++p) {
        if (p == 1 + PPL) continue;
        a.ph_lo = p; a.ph_hi = p + 1;
        float* lnsave = (float*)((char*)d_ws + WS_LSE); unsigned* tcnt = (unsigned*)((char*)d_ws + WS_LSE + 512 * 1024);
        if (p == 11 || p == 11 + PPL) hipLaunchKernelGGL(ln2_save, dim3(64), dim3(64), 0, stream, a, lnsave);
        hipLaunchKernelGGL(fwd_kernel, dim3(grid), dim3(NTHREADS), LDS_BYTES, stream, a);
        if (p == 11 || p == 11 + PPL) hipLaunchKernelGGL(chk_ln2, dim3(64), dim3(64), 0, stream, a, p == 11 ? 0 : 1, lnsave);
        if (p == 8 || p == 8 + PPL) { hipLaunchKernelGGL(chk_lists_zero, dim3(M / 256), dim3(256), 0, stream, tcnt); hipLaunchKernelGGL(chk_lists_fill, dim3(32, 16), dim3(256), 0, stream, a, p == 8 ? 0 : 1, tcnt); hipLaunchKernelGGL(chk_lists_verify, dim3(M / 256), dim3(256), 0, stream, a, tcnt); }
        if (p == 0) { hipLaunchKernelGGL(chk_mod, dim3(2), dim3(256), 0, stream, a, 0); hipLaunchKernelGGL(chk_mod, dim3(2), dim3(256), 0, stream, a, 1); }
        if (p == 1) hipLaunchKernelGGL(chk_u, dim3(16), dim3(256), 0, stream, a, 0, a.in[IN_X]);
        if (p == 2) hipLaunchKernelGGL(chk_inproj, dim3(512), dim3(256), 0, stream, a, 0, 0);
        if (p == 3) { hipLaunchKernelGGL(chk_attn_ab<0>, dim3(64), dim3(64), 0, stream, a, 0); hipLaunchKernelGGL(chk_attn_ab<1>, dim3(64), dim3(64), 0, stream, a, 0);
                      hipLaunchKernelGGL(chk_attn_c, dim3(96), dim3(64), 0, stream, a, 0); hipLaunchKernelGGL(chk_attn_d, dim3(48), dim3(256), 0, stream, a, 0, (float*)d_out); }
        if (p == 4) hipLaunchKernelGGL(chk_combine, dim3(16), dim3(256), 0, stream, a);
        if (p == 5) hipLaunchKernelGGL(chk_inproj, dim3(512), dim3(256), 0, stream, a, 0, 1);
        if (p == 6) hipLaunchKernelGGL(chk_merge, dim3(256), dim3(256), 0, stream, a, 0);
        if (p == 7) hipLaunchKernelGGL(chk_outproj, dim3(256), dim3(256), 0, stream, a, 0);
        if (p == 8) hipLaunchKernelGGL(chk_ln1, dim3(128), dim3(64), 0, stream, a, 0, a.in[IN_X]);
        if (p == 10) hipLaunchKernelGGL(chk_moe, dim3(128), dim3(256), 0, stream, a, 0);
        if (p == 1 + PPL + 10) hipLaunchKernelGGL(chk_moe, dim3(128), dim3(256), 0, stream, a, 1);
        const int q1 = p - PPL;
        if (q1 == 2) hipLaunchKernelGGL(chk_inproj, dim3(512), dim3(256), 0, stream, a, 1, 0);
        if (q1 == 3) { hipLaunchKernelGGL(chk_attn_ab<0>, dim3(64), dim3(64), 0, stream, a, 1); hipLaunchKernelGGL(chk_attn_ab<1>, dim3(64), dim3(64), 0, stream, a, 1);
                       hipLaunchKernelGGL(chk_attn_c, dim3(96), dim3(64), 0, stream, a, 1); }
        if (q1 == 4) hipLaunchKernelGGL(chk_combine, dim3(16), dim3(256), 0, stream, a);
        if (q1 == 5) hipLaunchKernelGGL(chk_inproj, dim3(512), dim3(256), 0, stream, a, 1, 1);
        if (q1 == 6) hipLaunchKernelGGL(chk_merge, dim3(256), dim3(256), 0, stream, a, 1);
        if (q1 == 7) hipLaunchKernelGGL(chk_outproj, dim3(256), dim3(256), 0, stream, a, 1);
    }
    hipLaunchKernelGGL(report, dim3(1024), dim3(256), 0, stream, a, 1);
#else
    a.ph_lo = 0; a.ph_hi = N_PHASES;
    hipLaunchKernelGGL(fwd_kernel, dim3(grid), dim3(NTHREADS), LDS_BYTES, stream, a);
#endif
}
```

```cpp
#include <hip/hip_runtime.h>
#include <cstdio>
#include <cstdint>

#ifndef DBG
#define DBG 0
#endif

#define LAS __attribute__((address_space(3)))
#define GAS __attribute__((address_space(1)))
typedef unsigned short bf16_t;
typedef short bf16x8 __attribute__((ext_vector_type(8)));
typedef short s16x4 __attribute__((ext_vector_type(4)));
typedef float f32x2 __attribute__((ext_vector_type(2)));
typedef float f32x4 __attribute__((ext_vector_type(4)));
typedef float f32x16 __attribute__((ext_vector_type(16)));
typedef unsigned u32x2 __attribute__((ext_vector_type(2)));
typedef unsigned u32x4 __attribute__((ext_vector_type(4)));
typedef GAS unsigned gu32;

constexpr int D = 1024, NBATCH = 4, SEQ = 8192, M = NBATCH * SEQ, DEPTH = 2;
constexpr int INW = 8360;
constexpr int NPT = 17, NGT = 16;
constexpr int NWIN = (NPT + NGT) * 256;
constexpr int NEXP = 16, FFE = 256;
constexpr float LOG2E = 1.4426950408889634f;
constexpr int NBH = 24;
constexpr float ALPHA = 1.4142135623730951f;
constexpr float LN_EPS = 1e-5f;
constexpr float SC32 = 0.17677669529663687f * LOG2E;
constexpr float SC64 = 0.125f * LOG2E;
constexpr size_t TILE_E = (size_t)M * 256;
enum { T_AQ = 0, T_AK = 1, T_AV = 2, T_BQ = 3, T_BKV = 4, T_CQ = 5, T_CK = 8, T_CV = 11, T_DQ = 14, T_MISC = 15, T_IQ = 16 };

constexpr size_t MiB = 1u << 20;
constexpr size_t WS_CTL = 0, CTL_ZERO_BYTES = 1 * MiB;
constexpr size_t WS_MOD = 1 * MiB;
constexpr size_t WS_LAM = WS_MOD + 256 * 1024;
constexpr size_t WS_LSE = 2 * MiB;
constexpr size_t WS_LISTE = 4 * MiB;
constexpr size_t WS_LISTW = 6 * MiB;
constexpr size_t WS_WIN = 8 * MiB;
constexpr size_t WS_WB = 41 * MiB;
constexpr size_t WS_WO = 45 * MiB;
constexpr size_t WS_W1 = 49 * MiB;
constexpr size_t WS_W2 = 81 * MiB;
constexpr size_t WS_UBUF = 98 * MiB;
constexpr size_t WS_OBUF = 162 * MiB;
constexpr size_t WS_R1 = 226 * MiB;
constexpr size_t WS_IKC = 498 * MiB;
constexpr size_t WS_END = 500 * MiB;
constexpr size_t R1_H = 0, R1_Y0 = 48 * MiB, R1_Y1 = 112 * MiB;
constexpr int CW_TMO = 0, CW_CODE = 1;
constexpr int CW_BAR = 4096;
constexpr int CW_QATT = 8192;
constexpr int CW_ECNT = 9216;
constexpr int CW_ERR = 16384;

constexpr int LDS_BIG = 0, LDS_BIG_BYTES = 131072;
constexpr int LDS_AUX = 131328;
constexpr int LDS_MISC = 155904;
constexpr int LDS_BYTES = 160000;
constexpr int MISC_BARW = 0;

#define RLX_AGENT __ATOMIC_RELAXED, __HIP_MEMORY_SCOPE_AGENT
#define LDS_WAIT() asm volatile("s_waitcnt lgkmcnt(0)" ::: "memory")
#define VM_WAIT() asm volatile("s_waitcnt vmcnt(0)" ::: "memory")
typedef __bf16 bf16x2_t __attribute__((ext_vector_type(2)));
__device__ __forceinline__ unsigned cvt_pk_bf16(float lo, float hi) { f32x2 v = {lo, hi}; bf16x2_t b = __builtin_convertvector(v, bf16x2_t); return __builtin_bit_cast(unsigned, b); }
__device__ __forceinline__ float bf2f(unsigned short b) { return __uint_as_float((unsigned)b << 16); }
__device__ __forceinline__ float bflo(unsigned w) { return __uint_as_float(w << 16); }
__device__ __forceinline__ float bfhi(unsigned w) { return __uint_as_float(w & 0xffff0000u); }
__device__ __forceinline__ unsigned short f2bf(float f) { unsigned u = __float_as_uint(f); return (unsigned short)((u + 0x7fffu + ((u >> 16) & 1u)) >> 16); }
__device__ __forceinline__ int launder(int x) { asm volatile("" : "+v"(x)); return x; }
__device__ __forceinline__ int launder_si(int x) { asm volatile("" : "+s"(x)); return x; }
template <class T> __device__ __forceinline__ T* launder_s(T* p) { asm volatile("" : "+s"(p)); return p; }
__device__ __forceinline__ int lane_now() { int x; asm volatile("v_mbcnt_lo_u32_b32 %0, -1, 0\n\tv_mbcnt_hi_u32_b32 %0, -1, %0" : "=v"(x)); return x; }
template <int X> __device__ __forceinline__ float swz_xor(float v) {
    const int x = __float_as_int(v);
    if (X == 1) return __int_as_float(__builtin_amdgcn_update_dpp(0, x, 0xB1, 0xf, 0xf, false));
    if (X == 2) return __int_as_float(__builtin_amdgcn_update_dpp(0, x, 0x4E, 0xf, 0xf, false));
    if (X == 4) { int r = __builtin_amdgcn_update_dpp(0, x, 0x104, 0xf, 0x5, false);
                  r = __builtin_amdgcn_update_dpp(r, x, 0x114, 0xf, 0xa, false); return __int_as_float(r); }
    if (X == 8) return __int_as_float(__builtin_amdgcn_update_dpp(0, x, 0x128, 0xf, 0xf, false));
    return __int_as_float(__builtin_amdgcn_ds_swizzle(x, (X << 10) | 0x1f));
}
__device__ __forceinline__ unsigned wave_incl_scan(unsigned x) {
    x += (unsigned)__builtin_amdgcn_update_dpp(0, (int)x, 0x111, 0xf, 0xf, false);
    x += (unsigned)__builtin_amdgcn_update_dpp(0, (int)x, 0x112, 0xf, 0xf, false);
    x += (unsigned)__builtin_amdgcn_update_dpp(0, (int)x, 0x114, 0xf, 0xf, false);
    x += (unsigned)__builtin_amdgcn_update_dpp(0, (int)x, 0x118, 0xf, 0xf, false);
    x += (unsigned)__builtin_amdgcn_update_dpp(0, (int)x, 0x142, 0xa, 0xf, false);
    x += (unsigned)__builtin_amdgcn_update_dpp(0, (int)x, 0x143, 0xc, 0xf, false);
    return x;
}
__device__ __forceinline__ float wave_sum(float v) {
    v += swz_xor<1>(v); v += swz_xor<2>(v); v += swz_xor<4>(v); v += swz_xor<8>(v); v += swz_xor<16>(v);
    auto rr = __builtin_amdgcn_permlane32_swap(__float_as_uint(v), __float_as_uint(v), false, false);
    return __uint_as_float(rr[0]) + __uint_as_float(rr[1]);
}
__device__ __forceinline__ float fast_exp2(float x) { return __builtin_amdgcn_exp2f(x); }
__device__ __forceinline__ float fast_rcp(float x) { return __builtin_amdgcn_rcpf(x); }
__device__ __forceinline__ float sigmoidf_(float x) { return fast_rcp(1.0f + fast_exp2(-x * LOG2E)); }
__device__ __forceinline__ int t5_bucket(int n) {
    if (n < 16) return n;
    const float lr = logf((float)n / 16.0f) / 4.852030263919617f;
    int large = 16 + (int)(lr * 16.0f);
    return large < 31 ? large : 31;
}

struct Args { const float* in[21]; float* out; unsigned char* ws; int ph_lo, ph_hi; };
enum { IN_X = 0, IN_C, IN_REL, IN_WROUTER, IN_BROUTER, IN_WADA, IN_BADA, IN_WIN, IN_LAMQ, IN_LAMK, IN_SUBLN, IN_SINKS, IN_WBRANCH, IN_WOUT, IN_LN1G, IN_LN1B, IN_WEG, IN_WEU, IN_WED, IN_LN2G, IN_LN2B };
constexpr int NWAVES = 8, NTHREADS = 512;
struct Frame {
    LAS unsigned char* lds; int wave, G, vcu; gu32* ctl; unsigned char* ws;
    __device__ __forceinline__ int lane_() const { return lane_now(); }
    __device__ __forceinline__ int tid_() const { return wave * 64 + lane_now(); }
};

#define XB_TMO      128
#define XB_XCNT(j)  (256  + 64 * (j))
#define XB_XSUB(j)  (1280 + 64 * (j))
#define XB_XGEN(j)  (2304 + 64 * (j))
#define XB_TOP      3328
#define XB_TOPGEN   3392
#define XCD_BAR_WORDS 3456
#define XB_SPIN_CAP (1u << 18)
__device__ __forceinline__ unsigned xb_ld(unsigned* p)              { return __hip_atomic_load(p, __ATOMIC_RELAXED, __HIP_MEMORY_SCOPE_AGENT); }
__device__ __forceinline__ unsigned xb_add(unsigned* p, unsigned v) { return __hip_atomic_fetch_add(p, v, __ATOMIC_RELAXED, __HIP_MEMORY_SCOPE_AGENT); }
__device__ __forceinline__ unsigned xb_xcc_id() { return (unsigned)__builtin_amdgcn_s_getreg((3 << 11) | 20) & 0xFu; }
#define XB_SPIN(cond, bar) do { unsigned _sp = 0; while (cond) { __builtin_amdgcn_s_sleep(1); \
    if ((++_sp & 255u) == 0u) { if (xb_ld(&(bar)[XB_TMO])) break; if (_sp > XB_SPIN_CAP) { atomicAdd(&(bar)[XB_TMO], 1u); break; } } } } while (0)
struct XcdBarrier { unsigned* bar; unsigned x; volatile LAS unsigned* st; };
__device__ __forceinline__ XcdBarrier xcd_barrier_post(unsigned* bar, volatile LAS unsigned* st) {
    XcdBarrier b; b.bar = bar; b.x = xb_xcc_id(); b.st = st;
    if (threadIdx.x == 0) (void)xb_add(&bar[XB_XCNT(b.x)], 1u);
    return b;
}
__device__ __forceinline__ void xcd_barrier_complete(unsigned* bar, unsigned x, unsigned& nloc, unsigned& nx) {
    const unsigned G = gridDim.x * gridDim.y * gridDim.z;
    unsigned sum, cnt, mine, sp = 0u;
    for (;;) {
        sum = 0u; cnt = 0u; mine = 0u;
#pragma unroll
        for (unsigned j = 0; j < 16; ++j) { const unsigned c = xb_ld(&bar[XB_XCNT(j)]); sum += c; cnt += (c > 0u) ? 1u : 0u; mine = (j == x) ? c : mine; }
        if (sum == G) break;
        __builtin_amdgcn_s_sleep(1);
        if ((++sp & 255u) == 0u) { if (xb_ld(&bar[XB_TMO])) break; if (sp > XB_SPIN_CAP) { atomicAdd(&bar[XB_TMO], 1u); break; } }
    }
    nloc = mine > 0u ? mine : 1u; nx = cnt > 0u ? cnt : 1u;
}
__device__ __forceinline__ void xcd_barrier(const XcdBarrier& b) {
    asm volatile("s_waitcnt vmcnt(0)" ::: "memory");
    __syncthreads();
    if (threadIdx.x == 0) {
        unsigned* bar = b.bar;
        __builtin_amdgcn_s_waitcnt(0);
        unsigned nloc = b.st[0], nx = b.st[1];
        if (nloc == 0u) { xcd_barrier_complete(bar, b.x, nloc, nx); b.st[0] = nloc; b.st[1] = nx; }
        const unsigned old = xb_add(&bar[XB_XSUB(b.x)], 1u);
        const unsigned gen = old / nloc;
        if (old + 1u == (gen + 1u) * nloc) {
            __builtin_amdgcn_fence(__ATOMIC_RELEASE, "agent");
            asm volatile("s_waitcnt vmcnt(0)" ::: "memory");
            const unsigned og = xb_add(&bar[XB_TOP], 1u);
            const unsigned tg = og / nx;
            if (og + 1u == (tg + 1u) * nx) xb_add(&bar[XB_TOPGEN], 1u);
            else XB_SPIN(xb_ld(&bar[XB_TOPGEN]) == tg, bar);
            __builtin_amdgcn_fence(__ATOMIC_ACQUIRE, "agent");
            xb_add(&bar[XB_XGEN(b.x)], 1u);
            asm volatile("s_waitcnt vmcnt(0)" ::: "memory");
        } else {
            XB_SPIN(xb_ld(&bar[XB_XGEN(b.x)]) == gen, bar);
            __builtin_amdgcn_fence(__ATOMIC_ACQUIRE, "agent");
            asm volatile("s_waitcnt vmcnt(0)" ::: "memory");
        }
    }
    __syncthreads();
}

namespace pg8 {
constexpr int BM = 256, BK = 64, HALF = 128, HTB = HALF * BK * 2, STAGE_BYTES = 8 * HTB, NXCD = 8, WGM = 8;
__host__ __device__ __forceinline__ int lds_byte(int r, int c) { const int st = (r >> 4) * 2 + (c >> 5), rr = r & 15, cc = c & 31, ob = rr * 64 + cc * 2; return st * 1024 + (ob ^ (((ob >> 9) & 1) << 5)); }
__host__ __device__ __forceinline__ void stage_rc(int b, int& R, int& C) { const int st = b / 1024, sb = b % 1024, swz = sb ^ (((sb >> 9) & 1) << 5); R = (st >> 1) * 16 + swz / 64; C = (st & 1) * 32 + (swz % 64) / 2; }
__host__ __device__ __forceinline__ int perm32(int rho) { const int n = rho >> 4, i = rho & 15; return 8 * (i >> 2) + 4 * n + (i & 3); }
struct Unit { int pm, pn, e, rt, ce; };

struct FullOrder {
    const char* A; const char* Bt; int K, lda; int nM, nN, nwg, G, c;
    __device__ __forceinline__ void init(const void* A_, int lda_, const void* Bt_, int K_, int M_, int N_, int G_, int c_) { A = (const char*)A_; Bt = (const char*)Bt_; K = K_; lda = lda_; nM = M_ / BM; nN = N_ / BM; nwg = nM * nN; G = G_; c = c_; }
    __device__ __forceinline__ bool next(int i, Unit& u) const {
        const long L = (long)i * G + c; if (L >= nwg) return false;
        int wgid = (int)L; { const int q = nwg / NXCD, r = nwg % NXCD, xcd = wgid % NXCD, off = wgid / NXCD; wgid = (xcd < r ? xcd * (q + 1) : r * (q + 1) + (xcd - r) * q) + off; }
        const int nig = WGM * nN, gid = wgid / nig, fm = gid * WGM, gsz = (nM - fm) < WGM ? (nM - fm) : WGM;
        u.pm = fm + ((wgid % nig) % gsz); u.pn = (wgid % nig) / gsz; u.e = 0; u.rt = 0; u.ce = 0; return true;
    }
    __device__ __forceinline__ const char* ptrA(const Unit& u) const { return A + (size_t)u.pm * BM * lda * 2; }
    __device__ __forceinline__ const char* ptrB(const Unit& u) const { return Bt + (size_t)u.pn * BM * K * 2; }
    __device__ __forceinline__ unsigned rowoffA(const Unit&, int) const { return 0u; }
    __device__ __forceinline__ unsigned rowrawA(const Unit&, int) const { return 0u; }
    __device__ __forceinline__ unsigned rowcvtA(unsigned) const { return 0u; }
};

#define PG8_SA(b, h) (((b) * 2 + (h)) * HTB)
#define PG8_SB(b, h) ((4 + (b) * 2 + (h)) * HTB)
#define PG8_WAIT_V(n) asm volatile("s_waitcnt vmcnt(" #n ")" ::: "memory")
#define PG8_WAIT_L(n) asm volatile("s_waitcnt lgkmcnt(" #n ")" ::: "memory")
#define PG8_BAR __builtin_amdgcn_s_barrier()
#define PG8_SCHED __builtin_amdgcn_sched_barrier(0)
#define PG8_WAIT_VL do { if constexpr (HALFN) PG8_WAIT_V(6); else PG8_WAIT_V(8); } while (0)
#define PG8_WAIT_VL0 do { if constexpr (HALFN) { if (t == 0) PG8_WAIT_V(14); else PG8_WAIT_V(6); } else PG8_WAIT_V(8); } while (0)

template <class Epi, class Sched, bool ALIGN_EPI, bool GATHER, bool HALFN = false>
__device__ __forceinline__ void gemm_phase(LAS unsigned char* lds, const Sched& S, const Epi& E, int wave_) {
    const int wid = __builtin_amdgcn_readfirstlane(wave_), lane = lane_now(), tid = wid * 64 + lane, wr = wid >> 2, wc = wid & 3, fr = lane & 15, fq = lane >> 4;
    const int K = S.K, nt = K / BK, lda = S.lda;
    unsigned voffA[2], voffB[2]; int RA[2], CA[2];
#pragma unroll
    for (int i = 0; i < 2; ++i) { int R, C; stage_rc(tid * 16 + i * 8192, R, C); const int Rb = (R & ~31) + perm32(R & 31);
        voffA[i] = (unsigned)(R * lda + C) * 2u; voffB[i] = (unsigned)(Rb * K + C) * 2u; RA[i] = R; CA[i] = C; }
    const size_t kstep = (size_t)(BK * 2);
    const size_t hstepA = (size_t)HALF * lda * 2, hstepB = (size_t)HALF * K * 2;
    const unsigned ldsw = (unsigned)wid * 1024u;
    const int aoff = lds_byte(wr * 64 + fr, fq * 8), boff = lds_byte(wc * 32 + fr, fq * 8);
    unsigned vAc[2][2], vAn[2][2];
#define PG8_STG(bufoff, gptr, v0, v1) do { \
        __builtin_amdgcn_global_load_lds((const unsigned*)((const char*)(gptr) + (v0)), (LAS unsigned*)(lds + (bufoff) + ldsw), 16, 0, 0); \
        __builtin_amdgcn_global_load_lds((const unsigned*)((const char*)(gptr) + (v1)), (LAS unsigned*)(lds + (bufoff) + ldsw + 8192), 16, 0, 0); } while (0)
#define PG8_STB(b, h, ptr) PG8_STG(PG8_SB(b, h), (ptr) + (h) * hstepB, voffB[0], voffB[1])
#define PG8_STA(b, h, ptr, nx) do { if constexpr (GATHER) { const unsigned v0_ = (nx) ? vAn[h][0] : vAc[h][0], v1_ = (nx) ? vAn[h][1] : vAc[h][1]; PG8_STG(PG8_SA(b, h), (ptr), v0_, v1_); } \
        else { PG8_STG(PG8_SA(b, h), (ptr) + (h) * hstepA, voffA[0], voffA[1]); } } while (0)
#define PG8_LDA(dst, b, h) do { _Pragma("unroll") for (int m = 0; m < 4; ++m) _Pragma("unroll") for (int k = 0; k < 2; ++k) dst[m][k] = *(const LAS bf16x8*)(lds + PG8_SA(b, h) + aoff + m * 2048 + k * 1024); } while (0)
#define PG8_LDB(dst, b, h) do { _Pragma("unroll") for (int n = 0; n < 2; ++n) _Pragma("unroll") for (int k = 0; k < 2; ++k) dst[n][k] = *(const LAS bf16x8*)(lds + PG8_SB(b, h) + boff + n * 2048 + k * 1024); } while (0)
#define PG8_MMA(ai, bj, At, Bt) do { __builtin_amdgcn_s_setprio(1); _Pragma("unroll") for (int m = 0; m < 4; ++m) _Pragma("unroll") for (int n = 0; n < 2; ++n) _Pragma("unroll") for (int k = 0; k < 2; ++k) \
        acc[ai][bj][m][n] = __builtin_amdgcn_mfma_f32_16x16x32_bf16(Bt[n][k], At[m][k], acc[ai][bj][m][n], 0, 0, 0); __builtin_amdgcn_s_setprio(0); } while (0)
    Unit cur, nxt; int ui = 0;
    if (!S.next(0, cur)) return;
    f32x4 acc[2][2][4][2];
#pragma unroll
    for (int a = 0; a < 2; ++a)
#pragma unroll
        for (int b = 0; b < 2; ++b)
#pragma unroll
            for (int m = 0; m < 4; ++m)
#pragma unroll
                for (int n = 0; n < 2; ++n) acc[a][b][m][n] = (f32x4){0.f, 0.f, 0.f, 0.f};
    bf16x8 At[4][2], B0[2][2], B1[2][2];
    f32x4 ys[2][4][2]; u32x4 gpre[2][4];
#pragma unroll
    for (int a = 0; a < 2; ++a)
#pragma unroll
        for (int m = 0; m < 4; ++m) { ys[a][m][0] = (f32x4){0.f, 0.f, 0.f, 0.f}; ys[a][m][1] = (f32x4){0.f, 0.f, 0.f, 0.f}; }
    const char* cA = S.ptrA(cur); const char* cB = S.ptrB(cur);
    if constexpr (GATHER) {
#pragma unroll
        for (int h = 0; h < 2; ++h)
#pragma unroll
            for (int i = 0; i < 2; ++i) { vAc[h][i] = S.rowoffA(cur, h * HALF + RA[i]) + (unsigned)CA[i] * 2u; vAn[h][i] = vAc[h][i]; }
        __builtin_amdgcn_sched_barrier(0);
    }
    PG8_STB(0, 0, cB); if constexpr (!HALFN) PG8_STB(0, 1, cB); PG8_STA(0, 0, cA, false); PG8_STA(0, 1, cA, false);
    if (wr == 1) PG8_BAR;
    PG8_WAIT_V(2); PG8_BAR;
    PG8_STB(1, 0, cB + kstep); PG8_STA(1, 0, cA + kstep, false); if constexpr (!HALFN) PG8_STB(1, 1, cB + kstep);
    if constexpr (HALFN) PG8_WAIT_V(4); else PG8_WAIT_V(6);
    PG8_BAR;
    for (;;) {
        const bool has_next = S.next(ui + 1, nxt);
        const char* nA = has_next ? S.ptrA(nxt) : cA; const char* nB = has_next ? S.ptrB(nxt) : cB;
        if constexpr (GATHER) {
            if (has_next) {
#pragma unroll
                for (int h = 0; h < 2; ++h)
#pragma unroll
                    for (int i = 0; i < 2; ++i) vAn[h][i] = S.rowrawA(nxt, h * HALF + RA[i]);
                __builtin_amdgcn_sched_barrier(0);
#pragma unroll
                for (int h = 0; h < 2; ++h)
#pragma unroll
                    for (int i = 0; i < 2; ++i) vAn[h][i] = S.rowcvtA(vAn[h][i]) + (unsigned)CA[i] * 2u;
            }
        }
        if constexpr (HALFN) { E.prefetch(gpre, cur, wr, wc, fr, fq); __builtin_amdgcn_sched_barrier(0); }
        for (int t = 0; t < nt; t += 2) {
            const bool last = (t == nt - 2);
            const bool nx = last && has_next;
            const char* a1 = cA + (size_t)(t + 1) * kstep;
            const char* a2 = last ? nA : cA + (size_t)(t + 2) * kstep; const char* b2 = last ? nB : cB + (size_t)(t + 2) * kstep;
            const char* a3 = a2 + kstep; const char* b3 = b2 + kstep;
            PG8_LDB(B0, 0, 0); if constexpr (!HALFN) PG8_LDB(B1, 0, 1); PG8_SCHED; PG8_LDA(At, 0, 0); PG8_STA(1, 1, a1, false);
            PG8_WAIT_VL0; PG8_WAIT_L(0); PG8_BAR; PG8_MMA(0, 0, At, B0); if constexpr (!HALFN) PG8_MMA(0, 1, At, B1); PG8_BAR; PG8_SCHED;
            PG8_LDA(At, 0, 1); PG8_STB(0, 0, b2); if constexpr (!HALFN) PG8_STB(0, 1, b2); PG8_STA(0, 0, a2, nx);
            PG8_WAIT_VL0; PG8_WAIT_L(0); PG8_BAR; PG8_MMA(1, 0, At, B0); if constexpr (!HALFN) PG8_MMA(1, 1, At, B1); PG8_BAR; PG8_SCHED;
            PG8_LDB(B0, 1, 0); if constexpr (!HALFN) PG8_LDB(B1, 1, 1); PG8_SCHED; PG8_LDA(At, 1, 0); PG8_STA(0, 1, a2, nx);
            PG8_WAIT_VL; PG8_WAIT_L(0); PG8_BAR; PG8_MMA(0, 0, At, B0); if constexpr (!HALFN) PG8_MMA(0, 1, At, B1); PG8_BAR; PG8_SCHED;
            PG8_LDA(At, 1, 1); PG8_STB(1, 0, b3); if constexpr (!HALFN) PG8_STB(1, 1, b3); PG8_STA(1, 0, a3, nx);
            PG8_WAIT_VL; PG8_WAIT_L(0); PG8_BAR; PG8_MMA(1, 0, At, B0); if constexpr (!HALFN) PG8_MMA(1, 1, At, B1); PG8_BAR; PG8_SCHED;
        }
        if constexpr (ALIGN_EPI) { if (wr == 0) PG8_BAR; }
        if constexpr (HALFN) E(acc, ys, gpre, cur, wr, wc, fr, fq); else E(acc, cur, wr, wc, fr, fq);
        if (!has_next) break;
#pragma unroll
        for (int a = 0; a < 2; ++a)
#pragma unroll
            for (int b = 0; b < 2; ++b)
#pragma unroll
                for (int m = 0; m < 4; ++m)
#pragma unroll
                    for (int n = 0; n < 2; ++n) acc[a][b][m][n] = (f32x4){0.f, 0.f, 0.f, 0.f};
        cur = nxt; cA = nA; cB = nB; ++ui;
        if constexpr (GATHER) {
#pragma unroll
            for (int h = 0; h < 2; ++h)
#pragma unroll
                for (int i = 0; i < 2; ++i) vAc[h][i] = vAn[h][i];
        }
        if constexpr (ALIGN_EPI) { if (wr == 1) PG8_BAR; }
    }
    PG8_WAIT_V(0);
    if constexpr (!ALIGN_EPI) { if (wr == 0) PG8_BAR; }
    PG8_BAR;
#undef PG8_STG
#undef PG8_STB
#undef PG8_STA
#undef PG8_LDA
#undef PG8_LDB
#undef PG8_MMA
}

__device__ __forceinline__ u32x4 pack8(f32x4 v0, f32x4 v1) { u32x4 w; w.x = cvt_pk_bf16(v0[0], v0[1]); w.y = cvt_pk_bf16(v0[2], v0[3]); w.z = cvt_pk_bf16(v1[0], v1[1]); w.w = cvt_pk_bf16(v1[2], v1[3]); return w; }
__device__ __forceinline__ int perm_row(int grow, int lg) {
    const int t = grow & (SEQ - 1);
    return (grow & ~(SEQ - 1)) | ((t & ((1 << lg) - 1)) << (13 - lg)) | (t >> lg);
}
struct EpiInproj {
    bf16_t* R1; bf16_t* IKC;
    __device__ __forceinline__ void operator()(const f32x4 (&acc)[2][2][4][2], const Unit& u, int wr, int wc, int fr, int fq) const {
        const int pn = u.pn;
        float sc = 1.f; if (pn == T_AQ) sc = SC32; else if (pn == T_BQ || pn == T_DQ || (pn >= T_CQ && pn < T_CQ + 3)) sc = SC64;
        int lg = 0; if (pn >= T_CQ && pn < T_CV + 3) { const int g = (pn - T_CQ) % 3; lg = 2 * g; }
        bf16_t* base = R1 + (size_t)pn * TILE_E + wc * 32 + 8 * fq;
        const int row0 = u.pm * BM + wr * 64 + fr;
#pragma unroll
        for (int ai = 0; ai < 2; ++ai)
#pragma unroll
            for (int m = 0; m < 4; ++m) { const int grow = row0 + ai * HALF + m * 16; const int prow = perm_row(grow, lg); bf16_t* rowp = base + (size_t)prow * 256;
#pragma unroll
                for (int bj = 0; bj < 2; ++bj) *(u32x4*)(rowp + bj * HALF) = pack8(acc[ai][bj][m][0] * sc, acc[ai][bj][m][1] * sc);
                if (pn == T_MISC && wc == 0) *(u32x4*)(IKC + (size_t)grow * 32 + 8 * fq) = pack8(acc[ai][1][m][0], acc[ai][1][m][1]); }
    }
};

struct EpiGate {
    bf16_t* R1;
    __device__ __forceinline__ void operator()(const f32x4 (&acc)[2][2][4][2], const Unit& u, int wr, int wc, int fr, int fq) const {
        bf16_t* base = R1 + (size_t)u.pn * TILE_E + wc * 32 + 8 * fq;
        const int row0 = u.pm * BM + wr * 64 + fr;
#pragma unroll
        for (int ai = 0; ai < 2; ++ai)
#pragma unroll
            for (int m = 0; m < 4; ++m) { bf16_t* rowp = base + (size_t)(row0 + ai * HALF + m * 16) * 256;
#pragma unroll
                for (int bj = 0; bj < 2; ++bj) { f32x4 v0 = acc[ai][bj][m][0], v1 = acc[ai][bj][m][1];
#pragma unroll
                    for (int i = 0; i < 4; ++i) { v0[i] = sigmoidf_(v0[i]); v1[i] = sigmoidf_(v1[i]); }
                    *(u32x4*)(rowp + bj * HALF) = pack8(v0, v1); } }
    }
};
struct EpiPlain {
    bf16_t* O; int ldc;
    __device__ __forceinline__ void operator()(const f32x4 (&acc)[2][2][4][2], const Unit& u, int wr, int wc, int fr, int fq) const {
        bf16_t* base = O + u.pn * BM + wc * 32 + 8 * fq;
        const int row0 = u.pm * BM + wr * 64 + fr;
#pragma unroll
        for (int ai = 0; ai < 2; ++ai)
#pragma unroll
            for (int m = 0; m < 4; ++m) { bf16_t* rowp = base + (size_t)(row0 + ai * HALF + m * 16) * ldc;
#pragma unroll
                for (int bj = 0; bj < 2; ++bj) *(u32x4*)(rowp + bj * HALF) = pack8(acc[ai][bj][m][0], acc[ai][bj][m][1]); }
    }
};
__device__ __forceinline__ void unpack8(u32x4 w, f32x4& v0, f32x4& v1) { v0 = (f32x4){bflo(w.x), bfhi(w.x), bflo(w.y), bfhi(w.y)}; v1 = (f32x4){bflo(w.z), bfhi(w.z), bflo(w.w), bfhi(w.w)}; }
struct EpiMerge {
    const bf16_t* gates; bf16_t* Mg;
    __device__ __forceinline__ void operator()(const f32x4 (&acc)[2][2][4][2], const Unit& u, int wr, int wc, int fr, int fq) const {
        const bf16_t* gb = gates + (size_t)(u.e * 4 + u.pn) * TILE_E + wc * 32 + 8 * fq;
        bf16_t* mb = Mg + u.pn * BM + wc * 32 + 8 * fq;
        const int row0 = u.pm * BM + wr * 64 + fr;
#pragma unroll
        for (int ai = 0; ai < 2; ++ai) {
            u32x4 gv[4][2], ov[4][2];
#pragma unroll
            for (int m = 0; m < 4; ++m)
#pragma unroll
                for (int bj = 0; bj < 2; ++bj) { const size_t row = (size_t)(row0 + ai * HALF + m * 16); gv[m][bj] = *(const u32x4*)(gb + row * 256 + bj * HALF);
                    ov[m][bj] = (u32x4){0u, 0u, 0u, 0u}; if (u.e > 0) ov[m][bj] = *(const u32x4*)(mb + row * 1024 + bj * HALF); }
#pragma unroll
            for (int m = 0; m < 4; ++m)
#pragma unroll
                for (int bj = 0; bj < 2; ++bj) { const size_t row = (size_t)(row0 + ai * HALF + m * 16); f32x4 g0, g1, o0, o1; unpack8(gv[m][bj], g0, g1); unpack8(ov[m][bj], o0, o1);
                    *(u32x4*)(mb + row * 1024 + bj * HALF) = pack8(acc[ai][bj][m][0] * g0 + o0, acc[ai][bj][m][1] * g1 + o1); }
        }
    }
};
struct MergeOrder {
    FullOrder fo; const char* Wb;
    __device__ __forceinline__ bool next(int i, Unit& u) const { if (!fo.next(i >> 2, u)) return false; u.e = i & 3; return true; }
    int K, lda;
    __device__ __forceinline__ const char* ptrA(const Unit& u) const { return fo.A + ((size_t)u.pm * BM * 1024 + (size_t)u.e * 256) * 2; }
    __device__ __forceinline__ const char* ptrB(const Unit& u) const { return Wb + ((size_t)u.e * 1024 + (size_t)u.pn * BM) * 256 * 2; }
    __device__ __forceinline__ unsigned rowoffA(const Unit&, int) const { return 0u; }
    __device__ __forceinline__ unsigned rowrawA(const Unit&, int) const { return 0u; }
    __device__ __forceinline__ unsigned rowcvtA(unsigned) const { return 0u; }
};
struct EpiMergeH {
    const bf16_t* gates; bf16_t* Mg;
    __device__ __forceinline__ void prefetch(u32x4 (&gv)[2][4], const Unit& u, int wr, int wc, int fr, int fq) const {
        const char* gbu = (const char*)(gates + (size_t)(u.e * 4 + (u.pn >> 1)) * TILE_E + (u.pn & 1) * HALF + (size_t)u.pm * BM * 256);
        unsigned vo = (unsigned)((wr * 64 + fr) * 256 + wc * 32 + 8 * fq) * 2u; asm volatile("" : "+v"(vo));
#pragma unroll
        for (int ai = 0; ai < 2; ++ai)
#pragma unroll
            for (int m = 0; m < 4; ++m) gv[ai][m] = *(const u32x4*)(gbu + (vo + (unsigned)((ai * HALF + m * 16) * 512)));
    }
    __device__ __forceinline__ void operator()(const f32x4 (&acc)[2][2][4][2], f32x4 (&ys)[2][4][2], const u32x4 (&gv)[2][4], const Unit& u, int wr, int wc, int fr, int fq) const {
#pragma unroll
        for (int ai = 0; ai < 2; ++ai)
#pragma unroll
            for (int m = 0; m < 4; ++m) { f32x4 g0, g1; unpack8(gv[ai][m], g0, g1); ys[ai][m][0] += acc[ai][0][m][0] * g0; ys[ai][m][1] += acc[ai][0][m][1] * g1; }
        if (u.e == 3) {
            char* mbu = (char*)(Mg + u.pn * HALF + (size_t)u.pm * BM * 1024);
            unsigned so = (unsigned)((wr * 64 + fr) * 1024 + wc * 32 + 8 * fq) * 2u; asm volatile("" : "+v"(so));
#pragma unroll
            for (int ai = 0; ai < 2; ++ai)
#pragma unroll
                for (int m = 0; m < 4; ++m) { *(u32x4*)(mbu + (so + (unsigned)((ai * HALF + m * 16) * 2048))) = pack8(ys[ai][m][0], ys[ai][m][1]);
                    ys[ai][m][0] = (f32x4){0.f, 0.f, 0.f, 0.f}; ys[ai][m][1] = (f32x4){0.f, 0.f, 0.f, 0.f}; }
        }
    }
};
struct MergeOrderH {
    FullOrder fo; const char* Wb;
    __device__ __forceinline__ bool next(int i, Unit& u) const { if (!fo.next(i >> 2, u)) return false; u.e = i & 3; return true; }
    int K, lda;
    __device__ __forceinline__ const char* ptrA(const Unit& u) const { return fo.A + ((size_t)u.pm * BM * 1024 + (size_t)u.e * 256) * 2; }
    __device__ __forceinline__ const char* ptrB(const Unit& u) const { return Wb + ((size_t)u.e * 1024 + (size_t)u.pn * HALF) * 256 * 2; }
    __device__ __forceinline__ unsigned rowoffA(const Unit&, int) const { return 0u; }
    __device__ __forceinline__ unsigned rowrawA(const Unit&, int) const { return 0u; }
    __device__ __forceinline__ unsigned rowcvtA(unsigned) const { return 0u; }
};
struct MoeOrder {
    int pre[17]; int cnt[16]; int ncol, G, c; const char* A; const char* W; size_t wstride; const unsigned* liste; int K, lda;
    __device__ __forceinline__ void init(const gu32* ecnt, int ncol_, int G_, int c_) { int s = 0;
#pragma unroll
        for (int e = 0; e < 16; ++e) { int ce = (int)__hip_atomic_load(ecnt + 64 * e, RLX_AGENT); ce = ce > 32768 ? 32768 : ce; cnt[e] = ce; pre[e] = s; s += (ce + 255) >> 8; }
        pre[16] = s; ncol = ncol_; G = G_; c = c_; }
    __device__ __forceinline__ bool next(int i, Unit& u) const {
        const int L = i * G + c; if (L >= pre[16] * ncol) return false;
        const int rtg = L / ncol; u.pn = L - rtg * ncol; u.pm = rtg; int e = 0;
#pragma unroll
        for (int k = 1; k < 16; ++k) e += (rtg >= pre[k]) ? 1 : 0;
        u.e = e; int pe = 0;
#pragma unroll
        for (int k = 0; k < 16; ++k) pe = (k == e) ? pre[k] : pe;
        u.rt = rtg - pe; u.ce = count(e); return true; }
    __device__ __forceinline__ int count(int e) const { int ce = 0;
#pragma unroll
        for (int k = 0; k < 16; ++k) ce = (k == e) ? cnt[k] : ce;
        return ce; }
    __device__ __forceinline__ const char* ptrA(const Unit& u) const { return lda ? A + (size_t)u.pm * BM * lda * 2 : A; }
    __device__ __forceinline__ const char* ptrB(const Unit& u) const { return W + (size_t)u.e * wstride + (size_t)u.pn * BM * K * 2; }
    __device__ __forceinline__ unsigned rowoffA(const Unit& u, int r) const {
        const int ce = u.ce; int s = u.rt * 256 + r; s = s < ce ? s : ce - 1;
        return (liste[(size_t)u.e * 32768 + s] >> 1) * 2048u; }
    __device__ __forceinline__ unsigned rowrawA(const Unit& u, int r) const { const int ce = u.ce; int s = u.rt * 256 + r; s = s < ce ? s : ce - 1; return liste[(size_t)u.e * 32768 + s]; }
    __device__ __forceinline__ unsigned rowcvtA(unsigned raw) const { return (raw >> 1) * 2048u; }
};
struct EpiMoe1 {
    bf16_t* H;
    __device__ __forceinline__ void operator()(const f32x4 (&acc)[2][2][4][2], const Unit& u, int wr, int wc, int fr, int fq) const {
        bf16_t* base = H + u.pn * 128 + wc * 32 + 8 * fq;
        const int row0 = u.pm * BM + wr * 64 + fr;
#pragma unroll
        for (int ai = 0; ai < 2; ++ai)
#pragma unroll
            for (int m = 0; m < 4; ++m) { f32x4 v0, v1;
#pragma unroll
                for (int i = 0; i < 4; ++i) { const float g0 = acc[ai][0][m][0][i], g1 = acc[ai][0][m][1][i]; v0[i] = g0 * sigmoidf_(g0) * acc[ai][1][m][0][i]; v1[i] = g1 * sigmoidf_(g1) * acc[ai][1][m][1][i]; }
                *(u32x4*)(base + (size_t)(row0 + ai * HALF + m * 16) * 256) = pack8(v0, v1); }
    }
};
struct EpiMoe2 {
    bf16_t* Y0; bf16_t* Y1; const unsigned* liste; const float* listw;
    __device__ __forceinline__ void operator()(const f32x4 (&acc)[2][2][4][2], const Unit& u, int wr, int wc, int fr, int fq) const {
        const int ce = u.ce; const int col = u.pn * BM + wc * 32 + 8 * fq;
        unsigned ent[2][4]; float wgt[2][4];
#pragma unroll
        for (int ai = 0; ai < 2; ++ai)
#pragma unroll
            for (int m = 0; m < 4; ++m) { int s = u.rt * 256 + wr * 64 + fr + ai * HALF + m * 16; s = s < ce ? s : ce - 1; ent[ai][m] = liste[(size_t)u.e * 32768 + s]; wgt[ai][m] = listw[(size_t)u.e * 32768 + s]; }
        __builtin_amdgcn_sched_barrier(0);
#pragma unroll
        for (int ai = 0; ai < 2; ++ai)
#pragma unroll
            for (int m = 0; m < 4; ++m) { const int s = u.rt * 256 + wr * 64 + fr + ai * HALF + m * 16;
                if (s < ce) { bf16_t* rowp = Y0 + (size_t)(ent[ai][m] & 1u) * ((R1_Y1 - R1_Y0) / 2) + (size_t)(ent[ai][m] >> 1) * 1024 + col;
#pragma unroll
                    for (int bj = 0; bj < 2; ++bj) *(u32x4*)(rowp + bj * HALF) = pack8(acc[ai][bj][m][0] * wgt[ai][m], acc[ai][bj][m][1] * wgt[ai][m]); } }
    }
};
}


namespace att {
typedef LAS const char* lds_cptr;
constexpr int NSLOT = 3, SLOTB = 8192;
constexpr int L_K = 0, L_V = NSLOT * SLOTB, L_OST = 2 * NSLOT * SLOTB  , OST_BYTES = 8704  , L_LUT = L_OST + 8 * OST_BYTES  , LUT_OFF = 96, LUT_N = 1728;
constexpr int L_WSF = LDS_AUX;
constexpr int FAR_DIST = 1513;
static_assert(L_LUT + LUT_N * 4 <= LDS_BIG_BYTES, "attention LDS map");
__device__ __forceinline__ int crow(int r, int hi) { return (r & 3) + 8 * (r >> 2) + 4 * hi; }
#define SBAR() __builtin_amdgcn_sched_barrier(0)
__device__ __forceinline__ void glds16(const void* gsrc, unsigned lds_dst) { unsigned keep;
    asm volatile("s_mov_b32 %0, m0\n\ts_mov_b32 m0, %2\n\ts_nop 0\n\tglobal_load_lds_dwordx4 %1, off\n\ts_mov_b32 m0, %0" : "=&s"(keep) : "v"(gsrc), "s"(lds_dst) : "memory"); }
template <int D0, int ND> __device__ __forceinline__ void qkt(f32x16& p0, f32x16& p1, lds_cptr kp, const bf16x8* qr, float cinit) {
    f32x16 c;
#pragma unroll
    for (int r = 0; r < 16; ++r) c[r] = cinit;
#pragma unroll
    for (int d = 0; d < ND; ++d) {
        const bf16x8 b0 = *(const LAS bf16x8*)(kp + (D0 + d) * 2048);
        const bf16x8 b1 = *(const LAS bf16x8*)(kp + (D0 + d) * 2048 + 512);
        if (d == 0) { p0 = __builtin_amdgcn_mfma_f32_32x32x16_bf16(b0, qr[D0 + d], c, 0, 0, 0); p1 = __builtin_amdgcn_mfma_f32_32x32x16_bf16(b1, qr[D0 + d], c, 0, 0, 0); }
        else { p0 = __builtin_amdgcn_mfma_f32_32x32x16_bf16(b0, qr[D0 + d], p0, 0, 0, 0); p1 = __builtin_amdgcn_mfma_f32_32x32x16_bf16(b1, qr[D0 + d], p1, 0, 0, 0); }
    }
}
__device__ __forceinline__ void load_kfrags(bf16x8 (&kf)[8], lds_cptr kp) {
#pragma unroll
    for (int d = 0; d < 4; ++d) { kf[2 * d] = *(const LAS bf16x8*)(kp + d * 2048); kf[2 * d + 1] = *(const LAS bf16x8*)(kp + d * 2048 + 512); }
    SBAR();
}
template <int D0, int ND> __device__ __forceinline__ void qkt_f(f32x16& p0, f32x16& p1, const bf16x8 (&kf)[8], const bf16x8* qr, float cinit) {
    f32x16 c;
#pragma unroll
    for (int r = 0; r < 16; ++r) c[r] = cinit;
#pragma unroll
    for (int d = 0; d < ND; ++d) {
        if (d == 0) { p0 = __builtin_amdgcn_mfma_f32_32x32x16_bf16(kf[2 * (D0 + d)], qr[D0 + d], c, 0, 0, 0); p1 = __builtin_amdgcn_mfma_f32_32x32x16_bf16(kf[2 * (D0 + d) + 1], qr[D0 + d], c, 0, 0, 0); }
        else { p0 = __builtin_amdgcn_mfma_f32_32x32x16_bf16(kf[2 * (D0 + d)], qr[D0 + d], p0, 0, 0, 0); p1 = __builtin_amdgcn_mfma_f32_32x32x16_bf16(kf[2 * (D0 + d) + 1], qr[D0 + d], p1, 0, 0, 0); }
    }
}
__device__ __forceinline__ float rowmax(const f32x16& p0, const f32x16& p1) {
    float a = fmaxf(fmaxf(p0[0], p0[1]), p1[0]), b = fmaxf(fmaxf(p0[2], p0[3]), p1[1]); a = fmaxf(fmaxf(a, p1[2]), p1[3]);
#pragma unroll
    for (int r = 4; r < 16; r += 4) { a = fmaxf(fmaxf(a, p0[r]), p0[r + 1]); b = fmaxf(fmaxf(b, p0[r + 2]), p0[r + 3]); a = fmaxf(fmaxf(a, p1[r]), p1[r + 1]); b = fmaxf(fmaxf(b, p1[r + 2]), p1[r + 3]); }
    const float m = fmaxf(a, b);
    auto rr = __builtin_amdgcn_permlane32_swap(__float_as_uint(m), __float_as_uint(m), false, false);
    return fmaxf(__uint_as_float(rr[0]), __uint_as_float(rr[1]));
}
__device__ __forceinline__ float halves_sum(float v) { auto rr = __builtin_amdgcn_permlane32_swap(__float_as_uint(v), __float_as_uint(v), false, false); return __uint_as_float(rr[0]) + __uint_as_float(rr[1]); }
__device__ __forceinline__ void pv(f32x16* o, int vb, bf16x8 pa0, bf16x8 pa1, bf16x8 pa2, bf16x8 pa3) {
#pragma unroll
    for (int d0 = 0; d0 < 2; ++d0) { s16x4 lo[4], hi[4];
#pragma unroll
        for (int ks = 0; ks < 4; ++ks) {
            asm volatile("ds_read_b64_tr_b16 %0,%1 offset:%c2" : "=&v"(lo[ks]) : "v"(vb), "i"(d0 * 4096 + ks * 1024) : "memory");
            asm volatile("ds_read_b64_tr_b16 %0,%1 offset:%c2" : "=&v"(hi[ks]) : "v"(vb), "i"(d0 * 4096 + ks * 1024 + 512) : "memory"); }
        asm volatile("s_waitcnt lgkmcnt(0)" ::: "memory"); SBAR();
#define PK(k) (bf16x8){lo[k][0], lo[k][1], lo[k][2], lo[k][3], hi[k][0], hi[k][1], hi[k][2], hi[k][3]}
        o[d0] = __builtin_amdgcn_mfma_f32_32x32x16_bf16(pa0, PK(0), o[d0], 0, 0, 0);
        o[d0] = __builtin_amdgcn_mfma_f32_32x32x16_bf16(pa1, PK(1), o[d0], 0, 0, 0);
        o[d0] = __builtin_amdgcn_mfma_f32_32x32x16_bf16(pa2, PK(2), o[d0], 0, 0, 0);
        o[d0] = __builtin_amdgcn_mfma_f32_32x32x16_bf16(pa3, PK(3), o[d0], 0, 0, 0);
#undef PK
    }
}
__device__ __forceinline__ void softmax_pv(f32x16& p0, f32x16& p1, float& m, float& l, f32x16* o, int vb, LAS float* wsf, int r32, int hi) {
    const float rm = rowmax(p0, p1);
    if (__any(rm > m + 8.0f)) {
        const float mn = fmaxf(m, rm), f = fast_exp2(m - mn); l *= f; m = mn;
        if (hi == 0) wsf[r32] = f;
        LDS_WAIT();
#pragma unroll
        for (int r = 0; r < 16; ++r) { const float fr_ = wsf[crow(r, hi)]; o[0][r] *= fr_; o[1][r] *= fr_; }
    }
    float s = 0.f;
#pragma unroll
    for (int r = 0; r < 16; ++r) { p0[r] = fast_exp2(p0[r] - m); p1[r] = fast_exp2(p1[r] - m); s += p0[r] + p1[r]; }
    l += s;
    u32x4 w0, w1, w2, w3;
    w0 = (u32x4){cvt_pk_bf16(p0[0], p0[1]), cvt_pk_bf16(p0[2], p0[3]), cvt_pk_bf16(p0[4], p0[5]), cvt_pk_bf16(p0[6], p0[7])};
    w1 = (u32x4){cvt_pk_bf16(p0[8], p0[9]), cvt_pk_bf16(p0[10], p0[11]), cvt_pk_bf16(p0[12], p0[13]), cvt_pk_bf16(p0[14], p0[15])};
    w2 = (u32x4){cvt_pk_bf16(p1[0], p1[1]), cvt_pk_bf16(p1[2], p1[3]), cvt_pk_bf16(p1[4], p1[5]), cvt_pk_bf16(p1[6], p1[7])};
    w3 = (u32x4){cvt_pk_bf16(p1[8], p1[9]), cvt_pk_bf16(p1[10], p1[11]), cvt_pk_bf16(p1[12], p1[13]), cvt_pk_bf16(p1[14], p1[15])};
    pv(o, vb, __builtin_bit_cast(bf16x8, w0), __builtin_bit_cast(bf16x8, w1), __builtin_bit_cast(bf16x8, w2), __builtin_bit_cast(bf16x8, w3));
}
__device__ __forceinline__ void softmax_pack(f32x16& p0, f32x16& p1, float& m, float& l, f32x16* o, LAS float* wsf, int r32, int hi, bf16x8 (&pa)[4]) {
    const float rm = rowmax(p0, p1);
    if (__any(rm > m + 8.0f)) {
        const float mn = fmaxf(m, rm), f = fast_exp2(m - mn); l *= f; m = mn;
        if (hi == 0) wsf[r32] = f;
        LDS_WAIT();
#pragma unroll
        for (int r = 0; r < 16; ++r) { const float fr_ = wsf[crow(r, hi)]; o[0][r] *= fr_; o[1][r] *= fr_; }
    }
    float s = 0.f;
#pragma unroll
    for (int r = 0; r < 16; ++r) { p0[r] = fast_exp2(p0[r] - m); p1[r] = fast_exp2(p1[r] - m); s += p0[r] + p1[r]; }
    l += s;
    pa[0] = __builtin_bit_cast(bf16x8, (u32x4){cvt_pk_bf16(p0[0], p0[1]), cvt_pk_bf16(p0[2], p0[3]), cvt_pk_bf16(p0[4], p0[5]), cvt_pk_bf16(p0[6], p0[7])});
    pa[1] = __builtin_bit_cast(bf16x8, (u32x4){cvt_pk_bf16(p0[8], p0[9]), cvt_pk_bf16(p0[10], p0[11]), cvt_pk_bf16(p0[12], p0[13]), cvt_pk_bf16(p0[14], p0[15])});
    pa[2] = __builtin_bit_cast(bf16x8, (u32x4){cvt_pk_bf16(p1[0], p1[1]), cvt_pk_bf16(p1[2], p1[3]), cvt_pk_bf16(p1[4], p1[5]), cvt_pk_bf16(p1[6], p1[7])});
    pa[3] = __builtin_bit_cast(bf16x8, (u32x4){cvt_pk_bf16(p1[8], p1[9]), cvt_pk_bf16(p1[10], p1[11]), cvt_pk_bf16(p1[12], p1[13]), cvt_pk_bf16(p1[14], p1[15])});
}
__device__ __forceinline__ void softmax_pack_rel(f32x16& p0, f32x16& p1, float& m, float& l, f32x16* o, LAS float* wsf, int r32, int hi, bf16x8 (&pa)[4], bool first) {
    const float rm = rowmax(p0, p1);
    if (first || __any(rm > 8.0f)) {
        const float dl = first ? fmaxf(rm, -100.f) : fmaxf(rm, 0.f), f = fast_exp2(-dl); m += dl; l *= f;
#pragma unroll
        for (int r = 0; r < 16; ++r) { p0[r] -= dl; p1[r] -= dl; }
        if (!first) {
            if (hi == 0) wsf[r32] = f;
            LDS_WAIT();
#pragma unroll
            for (int r = 0; r < 16; ++r) { const float fr_ = wsf[crow(r, hi)]; o[0][r] *= fr_; o[1][r] *= fr_; }
        }
    }
    float s = 0.f;
#pragma unroll
    for (int r = 0; r < 16; ++r) { p0[r] = fast_exp2(p0[r]); p1[r] = fast_exp2(p1[r]); s += p0[r] + p1[r]; }
    l += s;
    pa[0] = __builtin_bit_cast(bf16x8, (u32x4){cvt_pk_bf16(p0[0], p0[1]), cvt_pk_bf16(p0[2], p0[3]), cvt_pk_bf16(p0[4], p0[5]), cvt_pk_bf16(p0[6], p0[7])});
    pa[1] = __builtin_bit_cast(bf16x8, (u32x4){cvt_pk_bf16(p0[8], p0[9]), cvt_pk_bf16(p0[10], p0[11]), cvt_pk_bf16(p0[12], p0[13]), cvt_pk_bf16(p0[14], p0[15])});
    pa[2] = __builtin_bit_cast(bf16x8, (u32x4){cvt_pk_bf16(p1[0], p1[1]), cvt_pk_bf16(p1[2], p1[3]), cvt_pk_bf16(p1[4], p1[5]), cvt_pk_bf16(p1[6], p1[7])});
    pa[3] = __builtin_bit_cast(bf16x8, (u32x4){cvt_pk_bf16(p1[8], p1[9]), cvt_pk_bf16(p1[10], p1[11]), cvt_pk_bf16(p1[12], p1[13]), cvt_pk_bf16(p1[14], p1[15])});
}
__device__ __forceinline__ void pv2(f32x16* oA, f32x16* oB, int vb, const bf16x8 (&pa)[4], const bf16x8 (&pb)[4]) {
#pragma unroll
    for (int d0 = 0; d0 < 2; ++d0) { s16x4 lo[4], hi[4];
#pragma unroll
        for (int ks = 0; ks < 4; ++ks) {
            asm volatile("ds_read_b64_tr_b16 %0,%1 offset:%c2" : "=&v"(lo[ks]) : "v"(vb), "i"(d0 * 4096 + ks * 1024) : "memory");
            asm volatile("ds_read_b64_tr_b16 %0,%1 offset:%c2" : "=&v"(hi[ks]) : "v"(vb), "i"(d0 * 4096 + ks * 1024 + 512) : "memory"); }
        asm volatile("s_waitcnt lgkmcnt(0)" ::: "memory"); SBAR();
#define PK(k) (bf16x8){lo[k][0], lo[k][1], lo[k][2], lo[k][3], hi[k][0], hi[k][1], hi[k][2], hi[k][3]}
#pragma unroll
        for (int k = 0; k < 4; ++k) { const bf16x8 vf = PK(k);
            oA[d0] = __builtin_amdgcn_mfma_f32_32x32x16_bf16(pa[k], vf, oA[d0], 0, 0, 0);
            oB[d0] = __builtin_amdgcn_mfma_f32_32x32x16_bf16(pb[k], vf, oB[d0], 0, 0, 0); }
#undef PK
    }
}
__device__ __forceinline__ void first_ref(f32x16& p0, f32x16& p1, float& m) {
    const float dl = fmaxf(rowmax(p0, p1), -100.f); m = dl;
#pragma unroll
    for (int r = 0; r < 16; ++r) { p0[r] -= dl; p1[r] -= dl; }
}
__device__ __forceinline__ void exp_pack(f32x16& p0, f32x16& p1, bf16x8 (&pa)[4]) {
#pragma unroll
    for (int r = 0; r < 16; ++r) { p0[r] = fast_exp2(p0[r]); p1[r] = fast_exp2(p1[r]); }
    pa[0] = __builtin_bit_cast(bf16x8, (u32x4){cvt_pk_bf16(p0[0], p0[1]), cvt_pk_bf16(p0[2], p0[3]), cvt_pk_bf16(p0[4], p0[5]), cvt_pk_bf16(p0[6], p0[7])});
    pa[1] = __builtin_bit_cast(bf16x8, (u32x4){cvt_pk_bf16(p0[8], p0[9]), cvt_pk_bf16(p0[10], p0[11]), cvt_pk_bf16(p0[12], p0[13]), cvt_pk_bf16(p0[14], p0[15])});
    pa[2] = __builtin_bit_cast(bf16x8, (u32x4){cvt_pk_bf16(p1[0], p1[1]), cvt_pk_bf16(p1[2], p1[3]), cvt_pk_bf16(p1[4], p1[5]), cvt_pk_bf16(p1[6], p1[7])});
    pa[3] = __builtin_bit_cast(bf16x8, (u32x4){cvt_pk_bf16(p1[8], p1[9]), cvt_pk_bf16(p1[10], p1[11]), cvt_pk_bf16(p1[12], p1[13]), cvt_pk_bf16(p1[14], p1[15])});
}
__device__ __forceinline__ void pv2s(f32x16* oA, f32x16* oB, f32x4& lsA, f32x4& lsB, int vb, const bf16x8 (&pa)[4], const bf16x8 (&pb)[4]) {
    const s16x4 ones = {0x3f80, 0x3f80, 0x3f80, 0x3f80};
#pragma unroll
    for (int d0 = 0; d0 < 2; ++d0) { s16x4 lo[4], hi[4];
#pragma unroll
        for (int ks = 0; ks < 4; ++ks) {
            asm volatile("ds_read_b64_tr_b16 %0,%1 offset:%c2" : "=&v"(lo[ks]) : "v"(vb), "i"(d0 * 4096 + ks * 1024) : "memory");
            asm volatile("ds_read_b64_tr_b16 %0,%1 offset:%c2" : "=&v"(hi[ks]) : "v"(vb), "i"(d0 * 4096 + ks * 1024 + 512) : "memory"); }
        asm volatile("s_waitcnt lgkmcnt(0)" ::: "memory"); SBAR();
#define PK(k) (bf16x8){lo[k][0], lo[k][1], lo[k][2], lo[k][3], hi[k][0], hi[k][1], hi[k][2], hi[k][3]}
#pragma unroll
        for (int k = 0; k < 4; ++k) { const bf16x8 vf = PK(k);
            oA[d0] = __builtin_amdgcn_mfma_f32_32x32x16_bf16(pa[k], vf, oA[d0], 0, 0, 0);
            oB[d0] = __builtin_amdgcn_mfma_f32_32x32x16_bf16(pb[k], vf, oB[d0], 0, 0, 0);
            const s16x4 ha = d0 ? __builtin_shufflevector(pa[k], pa[k], 4, 5, 6, 7) : __builtin_shufflevector(pa[k], pa[k], 0, 1, 2, 3);
            const s16x4 hb = d0 ? __builtin_shufflevector(pb[k], pb[k], 4, 5, 6, 7) : __builtin_shufflevector(pb[k], pb[k], 0, 1, 2, 3);
            lsA = __builtin_amdgcn_mfma_f32_4x4x4bf16_1k(ha, ones, lsA, 0, 0, 0);
            lsB = __builtin_amdgcn_mfma_f32_4x4x4bf16_1k(hb, ones, lsB, 0, 0, 0); }
#undef PK
    }
}
__device__ __forceinline__ float own_sum(const f32x4& ls, int lane) { const int j = lane & 3; return j == 0 ? ls[0] : j == 1 ? ls[1] : j == 2 ? ls[2] : ls[3]; }
__device__ __forceinline__ void lazy_rescale(f32x4& ls, float& m, f32x16* o, LAS float* wf, int r32, int hi, int lane) {
    const float lt = halves_sum(own_sum(ls, lane));
    const int e = (int)((__float_as_uint(lt) >> 23) & 0xffu) - 127, d = e > 20 ? e : 0;
    const float f = __uint_as_float((unsigned)(127 - d) << 23);
    m += (float)d;
    if (hi == 0) wf[r32] = f;
    LDS_WAIT();
#pragma unroll
    for (int r = 0; r < 16; ++r) { const float fr_ = wf[crow(r, hi)]; o[0][r] *= fr_; o[1][r] *= fr_; }
    const f32x4 f4 = *(const LAS f32x4*)(wf + (r32 & ~3));
    ls *= f4;
    LDS_WAIT();
}
__device__ __forceinline__ void add_lut(f32x16& p0, f32x16& p1, const LAS float* lp) {
    f32x16 b0, b1;
#pragma unroll
    for (int r = 0; r < 16; ++r) { const int c = (r & 3) + 8 * (r >> 2); b0[r] = lp[59 - c]; b1[r] = lp[27 - c]; }
    __builtin_amdgcn_sched_barrier(0);
    p0 += b0; p1 += b1;
}

struct UnitP { const bf16_t* Qh; const bf16_t* Kh; const bf16_t* Vh; long seqrow0; int v0, tlo, thi, wd; };
template <int TYPE, bool G1> __device__ __forceinline__ void attn_unit_g(Frame& F, const UnitP P, bf16_t* Oh  , int opitch,
                                                              float lam, float one_m_laminit, const float* subg, float sink2, float* lse_out  ) {
    constexpr int NMAP = (TYPE == 0) ? 2 : 1;
    const int lane = F.lane_(), r32 = lane & 31, hi = lane >> 5, wid = F.wave;
    const unsigned lds0 = (unsigned)(uintptr_t)(F.lds + LDS_BIG);
    LAS float* wsf = (LAS float*)(F.lds + L_WSF) + wid * 128;
    const LAS float* lut = (const LAS float*)(F.lds + LDS_BIG + L_LUT);
    const int qlo = P.v0 + 32 * wid, qhi = qlo + 31;
    bf16x8 qr[4];
    { const bf16_t* Qw = P.Qh + (P.seqrow0 + qlo + r32) * 256;
#pragma unroll
      for (int d0 = 0; d0 < 4; ++d0) qr[d0] = *(const bf16x8*)(Qw + d0 * 16 + hi * 8); }
    const bf16_t* ksrc = P.Kh + (P.seqrow0 + lane) * 256 + wid * 8;
    const bf16_t* vsrc = P.Vh + (P.seqrow0 + 16 * (wid & 3) + (lane >> 2)) * 256 + (wid >> 2) * 32 + (lane & 3) * 8;
    const unsigned kdst = lds0 + L_K + wid * 1024, vdst = lds0 + L_V + wid * 1024;
    const lds_cptr kp0 = (lds_cptr)(F.lds + LDS_BIG) + L_K + hi * 1024 + r32 * 16;
    const int vb0 = (int)(lds0 + L_V) + ((lane >> 4) & 1) * 32 + (lane & 3) * 8 + (4 * hi + ((lane & 15) >> 2)) * 64;
    float m[NMAP], l[NMAP]; f32x16 o[NMAP][2]; f32x4 ls[NMAP];
#pragma unroll
    for (int mp = 0; mp < NMAP; ++mp) { m[mp] = 0.f; l[mp] = 0.f; o[mp][0] = f32x16{}; o[mp][1] = f32x16{}; ls[mp] = f32x4{}; }
#define DMA_TILE(t, slot) do { glds16(ksrc + (long)(t) * 64 * 256, (unsigned)__builtin_amdgcn_readfirstlane(kdst + (slot) * SLOTB)); glds16(vsrc + (long)(t) * 64 * 256, (unsigned)__builtin_amdgcn_readfirstlane(vdst + (slot) * SLOTB)); } while (0)
    DMA_TILE(P.tlo, 0);
#pragma unroll
    for (int d0 = 0; d0 < 4; ++d0) asm volatile("" : "+v"(qr[d0]));
    constexpr bool g1 = G1;
    bf16x8 pa[4], pb[4]; bool seen = false; (void)seen;
#define STAGE1(t_) do { \
        const lds_cptr kp = kp0 + slot * SLOTB; \
        const bool farc = (TYPE == 0) && (qlo - (k0 + 63) >= FAR_DIST); \
        const float cinit = farc ? lut[LUT_OFF + FAR_DIST + 64] : 0.f; \
        const LAS float* lp = lut + LUT_OFF + (qlo + r32 - k0 - 4 * hi - 59); \
        bf16x8 kf[8]; load_kfrags(kf, kp); \
        if (TYPE == 0) { \
            const bool first = ((t_) == P.tlo); \
            { f32x16 p0, p1; qkt_f<0, 2>(p0, p1, kf, qr, cinit - m[0]); if (!farc) add_lut(p0, p1, lp); if (first) first_ref(p0, p1, m[0]); exp_pack(p0, p1, pa); } \
            { f32x16 p0, p1; qkt_f<2, 2>(p0, p1, kf, qr, cinit - m[NMAP - 1]); if (!farc) add_lut(p0, p1, lp); if (first) first_ref(p0, p1, m[NMAP - 1]); exp_pack(p0, p1, pb); } \
        } else { \
            f32x16 p0, p1; qkt_f<0, 4>(p0, p1, kf, qr, cinit - m[0]);       \
            add_lut(p0, p1, lp); \
            softmax_pack_rel(p0, p1, m[0], l[0], o[0], wsf, r32, hi, pa, !seen); seen = true; \
        } } while (0)
#define STAGE2(vb_) do { \
        if (TYPE == 0) { \
            pv2s(o[0], o[NMAP - 1], ls[0], ls[NMAP - 1], (vb_), pa, pb); \
            const float mx = fmaxf(fmaxf(fmaxf(ls[0][0], ls[0][1]), fmaxf(ls[0][2], ls[0][3])), fmaxf(fmaxf(ls[NMAP - 1][0], ls[NMAP - 1][1]), fmaxf(ls[NMAP - 1][2], ls[NMAP - 1][3]))); \
            if (__any(mx > 0x1p40f)) { lazy_rescale(ls[0], m[0], o[0], wsf, r32, hi, lane); lazy_rescale(ls[NMAP - 1], m[NMAP - 1], o[NMAP - 1], wsf + 32, r32, hi, lane); } \
        } else pv(o[0], (vb_), pa[0], pa[1], pa[2], pa[3]); } while (0)
#define TILE_HEAD() \
        const int nslot = (slot == NSLOT - 1) ? 0 : slot + 1; \
        asm volatile("s_waitcnt vmcnt(0) lgkmcnt(0)\n\ts_barrier" ::: "memory");       \
        if (t + 1 < P.thi) DMA_TILE(t + 1, nslot); \
        const int k0 = 64 * t; \
        const bool act = (k0 <= qhi && k0 + 63 >= qlo - P.wd)
    int slot = 0;
    if (!g1) {
        for (int t = P.tlo; t < P.thi; ++t) { TILE_HEAD();
            if (act) { STAGE1(t); STAGE2(vb0 + slot * SLOTB); }
            slot = nslot; }
    } else {
        bool pend = false; int pvb = 0;
        for (int t = P.tlo; t < P.thi; ++t) { TILE_HEAD();
            if (pend) STAGE2(pvb);
            pend = act;
            if (act) { STAGE1(t); pvb = vb0 + slot * SLOTB; }
            slot = nslot; }
        if (pend) STAGE2(pvb);
    }
#undef TILE_HEAD
#undef STAGE1
#undef STAGE2
#undef DMA_TILE
    LAS float* stg = (LAS float*)(F.lds + LDS_BIG + L_OST + wid * OST_BYTES);
    float lt[NMAP];
#pragma unroll
    for (int mp = 0; mp < NMAP; ++mp) { lt[mp] = halves_sum(TYPE == 0 ? own_sum(ls[mp], lane) : l[mp]); if (TYPE == 1) lt[mp] += fast_exp2(sink2 - m[mp]); if (hi == 0) wsf[32 + 32 * mp + r32] = lt[mp]; }
    LDS_WAIT();
    if (TYPE == 0) {
        float la[16], lb2[16];
#pragma unroll
        for (int r = 0; r < 16; ++r) { la[r] = wsf[32 + crow(r, hi)]; lb2[r] = wsf[64 + crow(r, hi)]; }
        __builtin_amdgcn_sched_barrier(0);
#pragma unroll
        for (int r = 0; r < 16; ++r) { const int orow = crow(r, hi); const float i0 = fast_rcp(la[r]), i1 = fast_rcp(lb2[r]) * lam;
#pragma unroll
            for (int d0 = 0; d0 < 2; ++d0) stg[orow * 68 + d0 * 32 + r32] = o[0][d0][r] * i0 - o[NMAP - 1][d0][r] * i1; }
        LDS_WAIT();
        const int row = lane >> 1, half = lane & 1; const LAS float* sp = stg + row * 68 + half * 32;
        float v[32]; float ss = 0.f;
#pragma unroll
        for (int i = 0; i < 32; i += 4) { const f32x4 x = *(const LAS f32x4*)(sp + i); v[i] = x[0]; v[i + 1] = x[1]; v[i + 2] = x[2]; v[i + 3] = x[3]; ss += x[0] * x[0] + x[1] * x[1] + x[2] * x[2] + x[3] * x[3]; }
        ss += swz_xor<1>(ss);
        const float rs = rsqrtf(ss * (1.0f / 64.0f) + 1e-5f) * one_m_laminit;
        bf16_t* op = Oh + (P.seqrow0 + qlo + row) * (long)opitch + half * 32;
#pragma unroll
        for (int i = 0; i < 32; i += 8) { u32x4 w; const float* g = subg + half * 32 + i;
            w.x = cvt_pk_bf16(v[i] * rs * g[0], v[i + 1] * rs * g[1]); w.y = cvt_pk_bf16(v[i + 2] * rs * g[2], v[i + 3] * rs * g[3]);
            w.z = cvt_pk_bf16(v[i + 4] * rs * g[4], v[i + 5] * rs * g[5]); w.w = cvt_pk_bf16(v[i + 6] * rs * g[6], v[i + 7] * rs * g[7]);
            *(u32x4*)(op + i) = w; }
    } else {
        bf16_t* sb = (bf16_t*)0; LAS bf16_t* stb = (LAS bf16_t*)stg; (void)sb;
        float la[16];
#pragma unroll
        for (int r = 0; r < 16; ++r) la[r] = wsf[32 + crow(r, hi)];
        __builtin_amdgcn_sched_barrier(0);
#pragma unroll
        for (int r = 0; r < 16; ++r) { const int orow = crow(r, hi); const float i0 = fast_rcp(la[r]);
#pragma unroll
            for (int d0 = 0; d0 < 2; ++d0) stb[orow * 72 + d0 * 32 + r32] = f2bf(o[0][d0][r] * i0); }
        if (TYPE == 2 && hi == 0) lse_out[(P.seqrow0 + qlo + r32) * 4] = m[0] + __log2f(lt[0]);
        LDS_WAIT();
#pragma unroll
        for (int i = 0; i < 4; ++i) { const int row = i * 8 + (lane >> 3), ch = lane & 7; const u32x4 v = *(const LAS u32x4*)(stb + row * 72 + ch * 8);
            *(u32x4*)(Oh + (P.seqrow0 + qlo + row) * (long)opitch + ch * 8) = v; }
    }
    LDS_WAIT();
}
template <int TYPE> __device__ __forceinline__ void attn_unit(Frame& F, const UnitP P, bf16_t* Oh, int opitch, float lam, float one_m_laminit, const float* subg, float sink2, float* lse_out) {
    if (F.wave < 4) attn_unit_g<TYPE, false>(F, P, Oh, opitch, lam, one_m_laminit, subg, sink2, lse_out);
    else attn_unit_g<TYPE, true>(F, P, Oh, opitch, lam, one_m_laminit, subg, sink2, lse_out);
}
#undef SBAR
}


namespace dsel {
using att::lds_cptr; using att::crow;
constexpr int NQ = 16, CAND_CAP = 512;
constexpr int Q_T = 64, Q_NEED = 80, Q_SELCNT = 96, Q_CANDCNT = 112, Q_NB = 128, Q_ABOVE = 144, Q_B1 = 160, Q_FLAG = 176;
constexpr int RELD_OFF = 1280;
constexpr int WSF_OFF = 2048;
constexpr int SEL_OFF = LDS_AUX;
constexpr int BIASK_OFF = LDS_AUX + 16384;
constexpr int HIST_Q = 8200;
__device__ __forceinline__ unsigned okey(float s) { const unsigned u = __float_as_uint(s); return u ^ (((int)u >> 31) | 0x80000000u); }
struct Ctx { const bf16_t* misc; const bf16_t* iq; const bf16_t* ikc; long rowb; int q0, NT; };
__device__ __forceinline__ void load_kf(bf16x8 (&kf)[4], const Ctx& C, int t, int fr, int fq) {
    const bf16_t* kr = C.ikc + (C.rowb + 64 * t + fr) * 32 + 8 * fq;
#pragma unroll
    for (int g = 0; g < 4; ++g) kf[g] = *(const bf16x8*)(kr + g * 16 * 32);
}
#define FMA_ABS4(S, A, W) asm volatile("v_fma_f32 %0, |%4|, %8, %0\n\tv_fma_f32 %1, |%5|, %8, %1\n\tv_fma_f32 %2, |%6|, %8, %2\n\tv_fma_f32 %3, |%7|, %8, %3" \
        : "+v"(S[0]), "+v"(S[1]), "+v"(S[2]), "+v"(S[3]) : "v"(A[0]), "v"(A[1]), "v"(A[2]), "v"(A[3]), "v"(W))
__device__ __forceinline__ void score_tile(f32x4 (&sc)[4], const bf16x8 (&kf)[4], const bf16x8 (&iqf)[8], const bf16x8 (&cq)[2], const float (&w)[8]) {
    float s[4][4];
#pragma unroll
    for (int g = 0; g < 4; ++g) { f32x4 l = __builtin_amdgcn_mfma_f32_16x16x32_bf16(kf[g], cq[1], (f32x4){0.f, 0.f, 0.f, 0.f}, 0, 0, 0); l = __builtin_amdgcn_mfma_f32_16x16x32_bf16(kf[g], cq[0], l, 0, 0, 0);
#pragma unroll
        for (int r = 0; r < 4; ++r) s[g][r] = l[r]; }
#pragma unroll
    for (int h = 0; h < 8; ++h) {
        f32x4 a0 = __builtin_amdgcn_mfma_f32_16x16x32_bf16(kf[0], iqf[h], (f32x4){0.f, 0.f, 0.f, 0.f}, 0, 0, 0);
        f32x4 a1 = __builtin_amdgcn_mfma_f32_16x16x32_bf16(kf[1], iqf[h], (f32x4){0.f, 0.f, 0.f, 0.f}, 0, 0, 0);
        f32x4 a2 = __builtin_amdgcn_mfma_f32_16x16x32_bf16(kf[2], iqf[h], (f32x4){0.f, 0.f, 0.f, 0.f}, 0, 0, 0);
        f32x4 a3 = __builtin_amdgcn_mfma_f32_16x16x32_bf16(kf[3], iqf[h], (f32x4){0.f, 0.f, 0.f, 0.f}, 0, 0, 0);
#pragma unroll
        for (int r = 0; r < 4; ++r) { s[0][r] = __builtin_fmaf(__builtin_fabsf(a0[r]), w[h], s[0][r]); s[1][r] = __builtin_fmaf(__builtin_fabsf(a1[r]), w[h], s[1][r]);
                                      s[2][r] = __builtin_fmaf(__builtin_fabsf(a2[r]), w[h], s[2][r]); s[3][r] = __builtin_fmaf(__builtin_fabsf(a3[r]), w[h], s[3][r]); }
    }
#pragma unroll
    for (int g = 0; g < 4; ++g) sc[g] = (f32x4){s[g][0], s[g][1], s[g][2], s[g][3]};
}
#undef FMA_ABS4
template <int EMIT> __device__ __forceinline__ void tile_elems(const f32x4 (&sc)[4], int t, int fq, LAS unsigned char* hist, LAS unsigned* selbm, LAS unsigned* candcnt, unsigned T, int sh, unsigned msk) {
    unsigned eqm = 0u;
#pragma unroll
    for (int g = 0; g < 4; ++g)
#pragma unroll
        for (int r = 0; r < 4; ++r) {
            const unsigned key = okey(sc[g][r]);
            if (EMIT == 0) { if ((((key >> 21) ^ T) & msk) == 0u) __hip_atomic_fetch_add((LAS unsigned*)(hist + (((key >> sh) & 2047u) << 2)), 1u, __ATOMIC_RELAXED, __HIP_MEMORY_SCOPE_WORKGROUP); }
            else { const unsigned p = key >> sh;
                if (p > T) { const int kv = 64 * t + 16 * g + 4 * fq + r; __hip_atomic_fetch_or(selbm + (kv >> 5), 1u << (kv & 31), __ATOMIC_RELAXED, __HIP_MEMORY_SCOPE_WORKGROUP); }
                eqm |= (p == T) ? (1u << (4 * g + r)) : 0u; }
        }
    if (EMIT == 1 && eqm != 0u) {
        unsigned pos = __hip_atomic_fetch_add(candcnt, (unsigned)__builtin_popcount(eqm), __ATOMIC_RELAXED, __HIP_MEMORY_SCOPE_WORKGROUP);
#pragma unroll
        for (int g = 0; g < 4; ++g)
#pragma unroll
            for (int r = 0; r < 4; ++r) if ((eqm >> (4 * g + r)) & 1u) { if (pos < (unsigned)CAND_CAP) *(LAS u32x2*)(hist + pos * 8) = (u32x2){okey(sc[g][r]), (unsigned)(64 * t + 16 * g + 4 * fq + r)}; ++pos; }
    }
}
template <int EMIT> __device__ __forceinline__ void pass(Frame& F, const Ctx& C, const bf16x8 (&iqf)[8], const bf16x8 (&cq)[2], const float (&w)[8], unsigned T, int sh, unsigned msk) {
    const int lane = F.lane_(), fr = lane & 15, fq = lane >> 4;
    LAS unsigned* MQ = (LAS unsigned*)(F.lds + LDS_MISC);
    LAS unsigned char* hist = F.lds + LDS_BIG + fr * (EMIT ? 4096 : HIST_Q);
    LAS unsigned* selbm = (LAS unsigned*)(F.lds + SEL_OFF) + fr * 256;
    const int qpos = C.q0 + fr;
    bf16x8 kf0[4], kf1[4];
    const int t0 = F.wave;
    if (t0 < C.NT) load_kf(kf0, C, t0, fr, fq);
    if (t0 + 8 < C.NT) load_kf(kf1, C, t0 + 8, fr, fq);
#define D_TILE(KF, tt) do { f32x4 sc[4]; score_tile(sc, KF, iqf, cq, w); if ((tt) + 16 < C.NT) load_kf(KF, C, (tt) + 16, fr, fq); \
        if ((tt) == C.NT - 1) { _Pragma("unroll") for (int g = 0; g < 4; ++g) _Pragma("unroll") for (int r = 0; r < 4; ++r) sc[g][r] = (64 * (tt) + 16 * g + 4 * fq + r <= qpos) ? sc[g][r] : -__builtin_inff(); } \
        tile_elems<EMIT>(sc, (tt), fq, hist, selbm, MQ + Q_CANDCNT + fr, T, sh, msk); } while (0)
#pragma clang loop unroll(disable)
    for (int t = t0; t < C.NT; t += 16) {
        D_TILE(kf0, t);
        if (t + 8 < C.NT) D_TILE(kf1, t + 8);
    }
#undef D_TILE
}
__device__ __forceinline__ void scan_hist(Frame& F, int q, unsigned target, unsigned& bin, unsigned& above, unsigned& nb, unsigned& total) {
    const int lane = F.lane_();
    const LAS unsigned char* hq = F.lds + LDS_BIG + q * HIST_Q;
    const LAS u32x2* hp = (const LAS u32x2*)(hq + (63 - lane) * 128);
    unsigned c = 0;
    { u32x2 xv[16];
#pragma unroll
      for (int i = 0; i < 16; ++i) xv[i] = hp[(i + lane) & 15];
      __builtin_amdgcn_sched_barrier(0);
#pragma unroll
      for (int i = 0; i < 16; ++i) c += xv[i].x + xv[i].y; }
    const unsigned x = wave_incl_scan(c);
    total = (unsigned)__builtin_amdgcn_readlane((int)x, 63);
    const unsigned S = x - c;
    const unsigned long long bm = __ballot((S < target) && (x >= target));
    if (bm == 0ull) { bin = 0u; above = 0u; nb = 0u; return; }
    const int src = (int)__builtin_ctzll(bm);
    const unsigned Ssrc = (unsigned)__builtin_amdgcn_readlane((int)S, src);
    const unsigned cnt = lane < 32 ? *(const LAS unsigned*)(hq + ((63 - src) * 32 + 31 - lane) * 4) : 0u;
    const unsigned P = wave_incl_scan(cnt);
    const unsigned long long hm = __ballot(lane < 32 && Ssrc + P >= target);
    const int js = hm ? (int)__builtin_ctzll(hm) : 31;
    const unsigned cj = (unsigned)__builtin_amdgcn_readlane((int)cnt, js), Pj = (unsigned)__builtin_amdgcn_readlane((int)P, js);
    bin = (unsigned)((63 - src) * 32 + 31 - js); above = Ssrc + Pj - cj; nb = cj;
}
__device__ __forceinline__ void zero_hist(Frame& F, int tid) {
    LAS u32x4* z = (LAS u32x4*)(F.lds + LDS_BIG);
    const unsigned z0 = (unsigned)launder(0); const u32x4 zz = (u32x4){z0, z0, z0, z0};
#pragma unroll
    for (int i = 0; i < 16; ++i) z[tid + i * NTHREADS] = zz;
    if (tid < 8) z[16 * NTHREADS + tid] = zz;
}
__device__ __forceinline__ void d_unit(Frame& F, const bf16_t* R1, bf16_t* OBUF, int b, int q0, unsigned nxt_unit) {
    const int tid = F.tid_(), lane = tid & 63, fr = lane & 15, fq = lane >> 4, r32 = lane & 31, hi = lane >> 5, wid = F.wave;
    LAS unsigned* MQ = (LAS unsigned*)(F.lds + LDS_MISC);
    Ctx C; C.misc = R1 + (size_t)T_MISC * TILE_E; C.iq = R1 + (size_t)T_IQ * TILE_E; C.ikc = (const bf16_t*)(F.ws + WS_IKC); C.rowb = (long)b * SEQ; C.q0 = q0; C.NT = q0 / 64 + 1;
    zero_hist(F, tid);
    { LAS u32x4* zb = (LAS u32x4*)(F.lds + SEL_OFF); const unsigned z0 = (unsigned)launder(0); const u32x4 zz = (u32x4){z0, z0, z0, z0}; zb[tid] = zz; zb[tid + NTHREADS] = zz; }
    if (tid < 128) MQ[Q_T + tid] = 0u;
    bf16x8 iqf[8], cq[2]; float w[8];
    { const bf16_t* qrow = C.iq + (C.rowb + q0 + fr) * 256 + 8 * fq;
#pragma unroll
      for (int h = 0; h < 8; ++h) iqf[h] = *(const bf16x8*)(qrow + h * 32);
      const bf16x8 wv = *(const bf16x8*)(C.misc + (C.rowb + q0 + fr) * 256 + 160);
#pragma unroll
      for (int h = 0; h < 8; ++h) w[h] = bf2f((unsigned short)wv[h]);
#pragma unroll
      for (int j = 0; j < 8; ++j) { float c = 0.f;
#pragma unroll
          for (int h = 0; h < 8; ++h) c = __builtin_fmaf(w[h], bf2f((unsigned short)iqf[h][j]), c);
          const unsigned short ch = f2bf(c); cq[0][j] = (short)ch; cq[1][j] = (short)f2bf(c - bf2f(ch)); } }
    __syncthreads();
    if (tid == 0) MQ[9] = nxt_unit;
    pass<0>(F, C, iqf, cq, w, 0u, 21, 0u);
    __syncthreads();
    for (int qi = 0; qi < 2; ++qi) { const int q = 2 * wid + qi; unsigned bin, above, nb, total;
        scan_hist(F, q, 256u, bin, above, nb, total);
        if (lane == 0) {
            if (q0 + q + 1 <= 256) { MQ[Q_T + q] = 3u; MQ[Q_NEED + q] = 0u; MQ[Q_NB + q] = 0u; MQ[Q_ABOVE + q] = total; MQ[Q_B1 + q] = 0xffffffffu; }
            else { MQ[Q_T + q] = bin; MQ[Q_NEED + q] = 256u - above; MQ[Q_NB + q] = nb; MQ[Q_ABOVE + q] = above; MQ[Q_B1 + q] = bin;
                   if (nb > (unsigned)CAND_CAP && nb != 256u - above) MQ[Q_FLAG] = 1u; }
        } }
    __syncthreads();
    int shift = 21;
    if (MQ[Q_FLAG] != 0u) {
        __syncthreads();
        zero_hist(F, tid);
        __syncthreads();
        pass<0>(F, C, iqf, cq, w, MQ[Q_B1 + fr], 10, 0xffffffffu);
        __syncthreads();
        for (int qi = 0; qi < 2; ++qi) { const int q = 2 * wid + qi;
            const unsigned b1 = MQ[Q_B1 + q];
            if (b1 != 0xffffffffu) { unsigned bin, above, nb, total; const unsigned need1 = MQ[Q_NEED + q], ab1 = MQ[Q_ABOVE + q];
                scan_hist(F, q, need1, bin, above, nb, total);
                if (lane == 0) { MQ[Q_T + q] = (b1 << 11) | bin; MQ[Q_NEED + q] = need1 - above; MQ[Q_NB + q] = nb; MQ[Q_ABOVE + q] = ab1 + above; } }
            else if (lane == 0) MQ[Q_T + q] = (3u << 11) | 2047u; }
        shift = 10;
        __syncthreads();
    }
    pass<1>(F, C, iqf, cq, w, MQ[Q_T + fr], shift, 0u);
    __syncthreads();
    for (int qi = 0; qi < 2; ++qi) { const int q = 2 * wid + qi;
        unsigned need = MQ[Q_NEED + q]; unsigned n = MQ[Q_CANDCNT + q]; if (n > (unsigned)CAND_CAP) n = CAND_CAP;
        if (need > n) need = n;
        if (need > 0u) {
            const LAS u32x2* cd = (const LAS u32x2*)(F.lds + LDS_BIG + q * 4096);
            unsigned ck[8], ci[8]; unsigned alive = 0u, chosen = 0u;
#pragma unroll
            for (int s = 0; s < 8; ++s) { const u32x2 e = cd[lane + 64 * s]; ck[s] = e.x; ci[s] = e.y; }
            __builtin_amdgcn_sched_barrier(0);
#pragma unroll
            for (int s = 0; s < 8; ++s) { const bool in = (unsigned)(lane + 64 * s) < n; ck[s] = in ? ck[s] : 0u; ci[s] = in ? 8191u - ci[s] : 0u; alive |= in ? (1u << s) : 0u; }
            const int nsl = (int)((n + 63u) >> 6);
            if (need < n) {
                unsigned nalive = n;
                for (int bit = shift + 12; bit >= 0 && need > 0u && need < nalive; --bit) {
                    unsigned cnt1 = 0u; unsigned bits = 0u;
#pragma unroll
                    for (int s = 0; s < 8; ++s) if (s < nsl) { const unsigned v = (bit >= 13) ? (ck[s] >> (bit - 13)) : (ci[s] >> bit); const bool on = ((alive >> s) & 1u) && (v & 1u);
                        bits |= on ? (1u << s) : 0u; cnt1 += (unsigned)__builtin_popcountll(__ballot(on)); }
                    if (cnt1 >= need) { alive &= bits; nalive = cnt1; } else { chosen |= bits; need -= cnt1; alive &= ~bits; nalive -= cnt1; }
                }
                if (need > 0u) chosen |= alive;
            } else chosen = alive;
            LAS unsigned* selbm = (LAS unsigned*)(F.lds + SEL_OFF) + q * 256;
#pragma unroll
            for (int s = 0; s < 8; ++s) if (s < nsl) { if ((chosen >> s) & 1u) { const unsigned kv = 8191u - ci[s]; __hip_atomic_fetch_or(selbm + (kv >> 5), 1u << (kv & 31), __ATOMIC_RELAXED, __HIP_MEMORY_SCOPE_WORKGROUP); } }
        }
    }
    __syncthreads();
    {
        const unsigned lds0 = (unsigned)(uintptr_t)(F.lds + LDS_BIG) + wid * 16384;
        LAS float* wsf = (LAS float*)(F.lds + LDS_MISC + WSF_OFF) + wid * 64;
        LAS float* biasK = (LAS float*)(F.lds + BIASK_OFF) + wid * 256;
        const LAS float* relD = (const LAS float*)(F.lds + LDS_MISC + RELD_OFF);
        lds_cptr kad[4];
#pragma unroll
        for (int d = 0; d < 4; ++d) kad[d] = (lds_cptr)(F.lds + LDS_BIG) + wid * 16384 + (r32 >> 3) * 1024 + (r32 & 7) * 128 + ((((2 * d + hi) ^ ((r32 >> 1) & 7))) << 4);
        const int vb = (int)(lds0 + 8192) + ((lane >> 4) & 1) * 32 + (lane & 3) * 8 + (4 * hi + ((lane & 15) >> 2)) * 64;
        const bf16_t* dq = R1 + (size_t)T_DQ * TILE_E;
        int ksel2[2]; bf16x8 qr2[2][4];
#pragma unroll
        for (int qi = 0; qi < 2; ++qi) { const int q = 2 * wid + qi;
            LAS unsigned* selbm = (LAS unsigned*)(F.lds + SEL_OFF) + q * 256; LAS unsigned short* sel = (LAS unsigned short*)selbm;
            const u32x4 bw = *(const LAS u32x4*)(selbm + 4 * lane);
            const unsigned c = (unsigned)(__builtin_popcount(bw.x) + __builtin_popcount(bw.y) + __builtin_popcount(bw.z) + __builtin_popcount(bw.w));
            const unsigned x = wave_incl_scan(c);
            int ks = (int)__builtin_amdgcn_readlane((int)x, 63); ksel2[qi] = ks > 256 ? 256 : ks;
            unsigned pos = x - c;
            LDS_WAIT();
            unsigned wds[4] = {bw.x, bw.y, bw.z, bw.w};
#pragma unroll
            for (int i = 0; i < 4; ++i) { unsigned wv = wds[i]; while (wv) { const int bpos = __builtin_ctz(wv); wv &= wv - 1u; if (pos < 256u) sel[pos] = (unsigned short)(128 * lane + 32 * i + bpos); ++pos; } }
#pragma unroll
            for (int d0 = 0; d0 < 4; ++d0) { qr2[qi][d0] = (bf16x8){0, 0, 0, 0, 0, 0, 0, 0}; if (r32 < 4) qr2[qi][d0] = *(const bf16x8*)(dq + (C.rowb + q0 + q) * 256 + r32 * 64 + d0 * 16 + hi * 8); } }
        asm volatile("s_waitcnt lgkmcnt(0)" ::: "memory");
        const int nt0 = (ksel2[0] + 63) >> 6, nt1 = (ksel2[1] + 63) >> 6, ntot = nt0 + nt1;
#define D_ISSUE_K(s_) do { const int qi_ = (s_) >= nt0 ? 1 : 0, tt_ = (s_) - (qi_ ? nt0 : 0); const int ks_ = qi_ ? ksel2[1] : ksel2[0]; const int qpos_ = q0 + 2 * wid + qi_; \
            const LAS unsigned short* sel_ = (const LAS unsigned short*)(F.lds + SEL_OFF) + (2 * wid + qi_) * 512; \
            const int j_ = 64 * tt_ + lane; const bool valid_ = j_ < ks_; const int idx_ = valid_ ? (int)sel_[j_] : 0; \
            int ik_[8]; \
            _Pragma("unroll") for (int b_ = 0; b_ < 8; ++b_) { const int jr_ = 64 * tt_ + 8 * b_ + (lane >> 3); ik_[b_] = (int)sel_[jr_ < ks_ ? jr_ : 0]; } \
            __builtin_amdgcn_sched_barrier(0); \
            _Pragma("unroll") for (int b_ = 0; b_ < 8; ++b_) { const int jr_ = 64 * tt_ + 8 * b_ + (lane >> 3); const int ir_ = jr_ < ks_ ? ik_[b_] : 0; \
                att::glds16(C.misc + (C.rowb + ir_) * 256 + (((lane & 7) ^ ((4 * (b_ & 1) + (lane >> 4)) & 7)) << 3), (unsigned)__builtin_amdgcn_readfirstlane(lds0 + b_ * 1024)); } \
            const int bk_ = t5_bucket(qpos_ - idx_); const f32x4 rb_ = *(const LAS f32x4*)(relD + bk_ * 4); const float ninf_ = -__builtin_inff(); \
            *(LAS f32x4*)(biasK + lane * 4) = valid_ ? rb_ : (f32x4){ninf_, ninf_, ninf_, ninf_}; } while (0)
#define D_ISSUE_V(s_) do { const int qi_ = (s_) >= nt0 ? 1 : 0, tt_ = (s_) - (qi_ ? nt0 : 0); const int ks_ = qi_ ? ksel2[1] : ksel2[0]; \
            const LAS unsigned short* sel_ = (const LAS unsigned short*)(F.lds + SEL_OFF) + (2 * wid + qi_) * 512; \
            int iv_[4];         \
            _Pragma("unroll") for (int p_ = 0; p_ < 4; ++p_) { const int jr_ = 64 * tt_ + 16 * p_ + (lane >> 2); iv_[p_] = (int)sel_[jr_ < ks_ ? jr_ : 0]; } \
            __builtin_amdgcn_sched_barrier(0); \
            _Pragma("unroll") for (int p_ = 0; p_ < 4; ++p_) { const int jr_ = 64 * tt_ + 16 * p_ + (lane >> 2); iv_[p_] = jr_ < ks_ ? iv_[p_] : 0; } \
            _Pragma("unroll") for (int p_ = 0; p_ < 8; ++p_) \
                att::glds16(C.misc + (C.rowb + iv_[p_ & 3]) * 256 + 64 + (p_ >> 2) * 32 + (lane & 3) * 8, (unsigned)__builtin_amdgcn_readfirstlane(lds0 + 8192 + p_ * 1024)); } while (0)
        float m = -1e30f, l = 0.f; f32x16 o[2]; o[0] = f32x16{}; o[1] = f32x16{};
        if (ntot > 0) { D_ISSUE_K(0); D_ISSUE_V(0); }
        asm volatile("s_waitcnt vmcnt(0)" ::: "memory");
        for (int s = 0; s < ntot; ++s) {
            const int qi = s >= nt0 ? 1 : 0; const bool lastt = (s == nt0 - 1) || (s == ntot - 1); const bool has_next = s + 1 < ntot;
            asm volatile("s_waitcnt vmcnt(8) lgkmcnt(0)" ::: "memory");
            bf16x8 kfr[8];
#pragma unroll
            for (int d = 0; d < 4; ++d) { kfr[2 * d] = *(const LAS bf16x8*)(kad[d]); kfr[2 * d + 1] = *(const LAS bf16x8*)(kad[d] + 4096); }
            __builtin_amdgcn_sched_barrier(0);
            f32x16 p0, p1; if (qi) att::qkt_f<0, 4>(p0, p1, kfr, qr2[1], 0.f); else att::qkt_f<0, 4>(p0, p1, kfr, qr2[0], 0.f);
#pragma unroll
            for (int r = 0; r < 16; ++r) { const int kv = crow(r, hi); p0[r] += biasK[kv * 4 + (r32 & 3)]; p1[r] += biasK[(kv + 32) * 4 + (r32 & 3)]; }
            LDS_WAIT();
            if (has_next) { D_ISSUE_K(s + 1); asm volatile("s_waitcnt vmcnt(8)" ::: "memory"); } else asm volatile("s_waitcnt vmcnt(0)" ::: "memory");
            att::softmax_pv(p0, p1, m, l, o, vb, wsf, r32, hi);
            LDS_WAIT();
            if (lastt) {
                const float lt = att::halves_sum(l);
                if (hi == 0) wsf[32 + r32] = lt;
                LDS_WAIT();
                const long grow = C.rowb + q0 + 2 * wid + qi;
                if (hi == 0) {
#pragma unroll
                    for (int r = 0; r < 4; ++r) { const float il = fast_rcp(wsf[32 + r]);
                        OBUF[grow * 1024 + 768 + r * 64 + r32] = f2bf(o[0][r] * il); OBUF[grow * 1024 + 768 + r * 64 + 32 + r32] = f2bf(o[1][r] * il); } }
                LDS_WAIT();
                m = -1e30f; l = 0.f; o[0] = f32x16{}; o[1] = f32x16{};
            }
            if (has_next) D_ISSUE_V(s + 1);
        }
        asm volatile("s_waitcnt vmcnt(0) lgkmcnt(0)" ::: "memory");
#undef D_ISSUE_K
#undef D_ISSUE_V
    }
}
}

constexpr int NU_A = 512, NU_D = 2048, NU_B = 512, NU_C = 1536, NU_ATT = NU_A + NU_D + NU_B + NU_C;
__device__ __forceinline__ void build_lut(Frame& F, const float* rel, int type, int h, int g) {
    LAS float* lut = (LAS float*)(F.lds + LDS_BIG + att::L_LUT);
    const float ninf = -__builtin_inff();
    for (int idx = F.tid_(); idx < att::LUT_N; idx += NTHREADS) { const int d = idx - att::LUT_OFF; float v;
        if (type == 0) v = d < 0 ? ninf : rel[t5_bucket(d) * NBH + h] * LOG2E;
        else if (type == 1) v = (d < 0 || d > 127) ? ninf : rel[t5_bucket(d) * NBH + 4 + h] * LOG2E;
        else v = (d < 0 || d > 128) ? ninf : rel[t5_bucket(d << (2 * g)) * NBH + 8 + 4 * g + h] * LOG2E;
        lut[idx] = v; }
}
#define ATT_FETCH_BEGIN() unsigned nxt_unit = 0u; if (F.tid_() == 0) nxt_unit = __hip_atomic_fetch_add(F.ctl + CW_QATT + 64 * l, 1u, RLX_AGENT); __syncthreads()
#define ATT_FETCH_END() __syncthreads(); if (F.tid_() == 0) MQ[8] = nxt_unit; __syncthreads(); n = (int)MQ[8]
__device__ __forceinline__ void attention_phase(Frame& F, const Args& a, int l) {
    bf16_t* const R1 = (bf16_t*)(F.ws + WS_R1); bf16_t* const OBUF = (bf16_t*)(F.ws + WS_OBUF);
    LAS unsigned* MQ = (LAS unsigned*)(F.lds + LDS_MISC);
    const float* rel = a.in[IN_REL];
    { const int t_ = F.tid_(); if (t_ < 128) ((LAS float*)(F.lds + LDS_MISC + dsel::RELD_OFF))[t_] = rel[(t_ >> 2) * NBH + 20 + (t_ & 3)] * LOG2E; }
    __syncthreads();
    if (F.tid_() == 0) MQ[8] = __hip_atomic_fetch_add(F.ctl + CW_QATT + 64 * l, 1u, RLX_AGENT);
    __syncthreads();
    int n = (int)MQ[8]; int lutkey = -1;
    {   const float lam = ((const float*)(F.ws + WS_LAM))[l], one_m = 1.0f - ((const float*)(F.ws + WS_LAM))[2 + l];
        while (n < NU_A) { ATT_FETCH_BEGIN();
            const int qb = 31 - (n >> 4), b = (n >> 2) & 3, h = n & 3;
            if (lutkey != h) { build_lut(F, rel, 0, h, 0); lutkey = h; } __syncthreads();
            att::UnitP P{R1 + (size_t)T_AQ * TILE_E + h * 64, R1 + (size_t)T_AK * TILE_E + h * 64, R1 + (size_t)T_AV * TILE_E + h * 64, (long)b * SEQ, qb * 256, 0, 4 * qb + 4, 1 << 30};
            att::attn_unit<0>(F, P, OBUF + h * 64, 1024, lam, one_m, a.in[IN_SUBLN] + l * 64, 0.f, nullptr);
            ATT_FETCH_END(); } }
    F.ws = (unsigned char*)launder_s((GAS unsigned char*)F.ws);
    while (n < NU_A + NU_D) { ATT_FETCH_BEGIN();
        const int i = n - NU_A; const int b = i >> 9, blk = 511 - (i & 511);
        dsel::d_unit(F, (bf16_t*)(F.ws + WS_R1), (bf16_t*)(F.ws + WS_OBUF), b, blk * 16, nxt_unit);
        __syncthreads(); n = (int)MQ[9]; lutkey = -1; }
    F.ws = (unsigned char*)launder_s((GAS unsigned char*)F.ws);
    while (n < NU_A + NU_D + NU_B) { ATT_FETCH_BEGIN();
        bf16_t* const R1b = (bf16_t*)(F.ws + WS_R1);
        const int j = n - NU_A - NU_D; const int qb = j & 31, b = (j >> 5) & 3, h = j >> 7;
        if (lutkey != 16 + h) { build_lut(F, rel, 1, h, 0); lutkey = 16 + h; } __syncthreads();
        const bf16_t* kv = R1b + (size_t)T_BKV * TILE_E + (h >> 1) * 64;
        att::UnitP P{R1b + (size_t)T_BQ * TILE_E + h * 64, kv, kv + 128, (long)b * SEQ, qb * 256, (4 * qb - 2) > 0 ? 4 * qb - 2 : 0, 4 * qb + 4, 127};
        att::attn_unit<1>(F, P, (bf16_t*)(F.ws + WS_OBUF) + 256 + h * 64, 1024, 0.f, 0.f, nullptr, a.in[IN_SINKS][l * 4 + h] * LOG2E, nullptr);
        ATT_FETCH_END(); }
    F.ws = (unsigned char*)launder_s((GAS unsigned char*)F.ws);
    while (n < NU_ATT) { ATT_FETCH_BEGIN();
        bf16_t* const R1c = (bf16_t*)(F.ws + WS_R1);
        const int j = n - NU_A - NU_D - NU_B; const int g = j >> 9, jj = j & 511, h = jj >> 7, blk = jj & 127, b = blk >> 5, vbk = blk & 31;
        const int lg = 2 * g, Lg = SEQ >> lg, vrow = vbk * 256, rho = vrow >> (13 - lg), v0 = vrow & (Lg - 1);
        if (lutkey != 32 + 4 * g + h) { build_lut(F, rel, 2, h, g); lutkey = 32 + 4 * g + h; } __syncthreads();
        bf16_t* qh = R1c + (size_t)(T_CQ + g) * TILE_E + h * 64;
        const int t0 = v0 / 64;
        att::UnitP P{qh, R1c + (size_t)(T_CK + g) * TILE_E + h * 64, R1c + (size_t)(T_CV + g) * TILE_E + h * 64, (long)b * SEQ + (long)rho * Lg, v0, (t0 - 2) > 0 ? t0 - 2 : 0, t0 + 4, 128};
        att::attn_unit<2>(F, P, qh, 256, 0.f, 0.f, nullptr, 0.f, (float*)(F.ws + WS_LSE) + (size_t)g * M * 4 + h);
        ATT_FETCH_END(); }
}
#undef ATT_FETCH_BEGIN
#undef ATT_FETCH_END

constexpr int PPL = 11;
constexpr int N_PHASES = 1 + PPL * DEPTH;


__device__ __forceinline__ void cvt_item(const float* src, int ldsrc, int srccol, int ncols, int k0, bf16_t* dstrow0, int Kdst, LAS float* scr, int lane) {
    const int c = lane & 31;
    float tv[32];
#pragma unroll
    for (int i = 0; i < 32; ++i) { const int kk = 2 * i + (lane >> 5); tv[i] = (c < ncols) ? src[(size_t)(k0 + kk) * ldsrc + srccol + c] : 0.f; }
#pragma unroll
    for (int i = 0; i < 32; ++i) { const int kk = 2 * i + (lane >> 5); scr[kk * 33 + c] = tv[i]; }
    LDS_WAIT(); asm volatile("" ::: "memory");
    const int c8 = lane & 7;
#pragma unroll
    for (int j = 0; j < 4; ++j) { const int n = (lane >> 3) + 8 * j; const LAS float* s = scr + (8 * c8) * 33 + n;
        u32x4 o; o.x = cvt_pk_bf16(s[0 * 33], s[1 * 33]); o.y = cvt_pk_bf16(s[2 * 33], s[3 * 33]); o.z = cvt_pk_bf16(s[4 * 33], s[5 * 33]); o.w = cvt_pk_bf16(s[6 * 33], s[7 * 33]);
        *(GAS u32x4*)(dstrow0 + (size_t)n * Kdst + k0 + 8 * c8) = o; }
    LDS_WAIT(); asm volatile("" ::: "memory");
}
__device__ __forceinline__ void win_colmap(int n0, int& srccol, int& ncols) {
    ncols = 32;
    if (n0 < 3968) srccol = n0;
    else if (n0 < 4000) srccol = 4224 + (n0 - 3968);
    else if (n0 == 4000) { srccol = 4256; ncols = 8; }
    else if (n0 < 4096) { srccol = 0; ncols = 0; }
    else if (n0 < 4352) srccol = 3968 + (n0 - 4096);
    else srccol = 4264 + (n0 - 4352);
}
__device__ __forceinline__ void p0_prologue(Frame& F, const Args& a) {
    const int tid = F.tid_(), lane = tid & 63;
    LAS float* sil = (LAS float*)(F.lds + LDS_BIG);
    LAS float* red = (LAS float*)(F.lds + LDS_BIG + 16384);
    float* mod = (float*)(F.ws + WS_MOD);
    if (F.vcu < 192) {
        for (int i = tid; i < 4096; i += NTHREADS) { const float cv = a.in[IN_C][i]; sil[i] = cv * sigmoidf_(cv); }
        __syncthreads();
        for (int it = F.vcu; it < 192; it += F.G) {
            const int l = it / 96, cg = it % 96, col = cg * 64 + lane;
            const float* w = a.in[IN_WADA] + (size_t)l * D * 6144 + col;
            float acc0 = 0.f, acc1 = 0.f, acc2 = 0.f, acc3 = 0.f;
            const int kb = F.wave * 128;
#pragma unroll 16
            for (int kk = 0; kk < 128; ++kk) { const int k = kb + kk; const float wv = w[(size_t)k * 6144];
                acc0 += sil[k] * wv; acc1 += sil[1024 + k] * wv; acc2 += sil[2048 + k] * wv; acc3 += sil[3072 + k] * wv; }
            red[(F.wave * 4 + 0) * 64 + lane] = acc0; red[(F.wave * 4 + 1) * 64 + lane] = acc1; red[(F.wave * 4 + 2) * 64 + lane] = acc2; red[(F.wave * 4 + 3) * 64 + lane] = acc3;
            __syncthreads();
            if (tid < 256) { const int b = tid >> 6, ln = tid & 63; float s = 0.f;
#pragma unroll
                for (int w8 = 0; w8 < 8; ++w8) s += red[(w8 * 4 + b) * 64 + ln];
                mod[((size_t)l * 4 + b) * 6144 + cg * 64 + ln] = s + a.in[IN_BADA][(size_t)l * 6144 + cg * 64 + ln]; }
            __syncthreads();
        }
    }
    if (F.vcu == 255 % F.G && F.wave == 0) {
        float* lam = (float*)(F.ws + WS_LAM);
        for (int l = 0; l < DEPTH; ++l) {
            const float* lq = a.in[IN_LAMQ] + l * 64; const float* lk = a.in[IN_LAMK] + l * 64;
            float p0 = lane < 32 ? lq[lane] * lk[lane] : 0.f, p1 = lane < 32 ? lq[32 + lane] * lk[32 + lane] : 0.f;
            p0 = wave_sum(p0); p1 = wave_sum(p1);
            const float lam_init = 0.8f - 0.6f * expf(-0.3f * (float)l);
            if (lane == 0) { lam[l] = expf(p0) - expf(p1) + lam_init; lam[2 + l] = lam_init; }
        }
    }
    __syncthreads();
    LAS float* scr = (LAS float*)(F.lds + LDS_BIG + F.wave * 16384);
    const int gw = F.vcu * NWAVES + F.wave, NGW = F.G * NWAVES;
    constexpr int I_A = 2 * 16 * 264, I_B = 2 * 4 * 4 * 32, I_C = 2 * 16 * 32, I_D = 2 * 16 * 16 * 16, I_E = 2 * 16 * 4 * 32;
    for (int it = gw; it < I_A + I_B + I_C + I_D + I_E; it += NGW) {
        int r = it;
        if (r < I_A) { const int l = r / 4224, q = r % 4224, kb = q / 264, nb = q % 264; int sc, nc; win_colmap(nb * 32, sc, nc);
            cvt_item(a.in[IN_WIN] + (size_t)l * D * INW, INW, sc, nc, kb * 64, (bf16_t*)(F.ws + WS_WIN) + ((size_t)l * NWIN + nb * 32) * D, D, scr, lane); continue; }
        r -= I_A;
        if (r < I_B) { const int li = r / 128, q = r % 128, kb = q / 32, nb = q % 32;
            cvt_item(a.in[IN_WBRANCH] + (size_t)li * 256 * D, D, nb * 32, 32, kb * 64, (bf16_t*)(F.ws + WS_WB) + ((size_t)li * D + nb * 32) * 256, 256, scr, lane); continue; }
        r -= I_B;
        if (r < I_C) { const int l = r / 512, q = r % 512, kb = q / 32, nb = q % 32;
            cvt_item(a.in[IN_WOUT] + (size_t)l * D * D, D, nb * 32, 32, kb * 64, (bf16_t*)(F.ws + WS_WO) + ((size_t)l * D + nb * 32) * D, D, scr, lane); continue; }
        r -= I_C;
        if (r < I_D) { const int le = r / 256, q = r % 256, kb = q / 16, nb = q % 16;
            const int n0 = nb * 32, ct = n0 >> 8, wi = n0 & 255; const float* src = (wi < 128 ? a.in[IN_WEG] : a.in[IN_WEU]) + (size_t)le * D * FFE;
            cvt_item(src, FFE, ct * 128 + (wi & 127), 32, kb * 64, (bf16_t*)(F.ws + WS_W1) + ((size_t)le * 512 + n0) * D, D, scr, lane); continue; }
        r -= I_D;
        { const int le = r / 128, q = r % 128, kb = q / 32, nb = q % 32;
            cvt_item(a.in[IN_WED] + (size_t)le * FFE * D, D, nb * 32, 32, kb * 64, (bf16_t*)(F.ws + WS_W2) + ((size_t)le * D + nb * 32) * FFE, FFE, scr, lane); }
    }
}
__device__ __forceinline__ void modulate_rows(Frame& F, const float* x, const float* modl  , int shift_idx, int scale_idx, bf16_t* out) {
    const int lane = F.lane_(); const int gw = F.vcu * NWAVES + F.wave, NGW = F.G * NWAVES;
    constexpr int RPW = 16;
    for (int chunk = gw; chunk < M / RPW; chunk += NGW) {
        const int m0 = chunk * RPW; const float* mb = modl + (size_t)(m0 >> 13) * 6144;
        f32x4 sc1[4], shv[4], xn[4];
#pragma unroll
        for (int j = 0; j < 4; ++j) { const int c = 4 * lane + 256 * j; sc1[j] = *(const f32x4*)(mb + scale_idx * D + c) + 1.0f; shv[j] = *(const f32x4*)(mb + shift_idx * D + c);
            xn[j] = ((const GAS f32x4*)(x + (size_t)m0 * D) + lane)[64 * j]; }
        for (int i = 0; i < RPW; ++i) { const int m = m0 + i;
            f32x4 xv[4];
#pragma unroll
            for (int j = 0; j < 4; ++j) xv[j] = xn[j];
            if (i + 1 < RPW) {
#pragma unroll
                for (int j = 0; j < 4; ++j) xn[j] = ((const GAS f32x4*)(x + (size_t)(m + 1) * D) + lane)[64 * j]; }
            GAS unsigned long long* o8 = (GAS unsigned long long*)(out + (size_t)m * D) + lane;
#pragma unroll
            for (int j = 0; j < 4; ++j) { const f32x4 r = xv[j] * sc1[j] + shv[j];
                o8[64 * j] = (unsigned long long)cvt_pk_bf16(r[0], r[1]) | ((unsigned long long)cvt_pk_bf16(r[2], r[3]) << 32); }
        }
    }
}
__device__ __forceinline__ void combine_c(Frame& F) {
    const int lane = F.lane_(); const int gw = F.vcu * NWAVES + F.wave, NGW = F.G * NWAVES;
    const bf16_t* R1 = (const bf16_t*)(F.ws + WS_R1); bf16_t* OB = (bf16_t*)(F.ws + WS_OBUF); const float* lse = (const float*)(F.ws + WS_LSE);
    const int h = lane >> 4;
    float lsn[3]; u32x2 ovn[3];
    if (gw < M) {
#pragma unroll
        for (int g = 0; g < 3; ++g) { const size_t pr = (size_t)pg8::perm_row(gw, 2 * g); lsn[g] = lse[((size_t)g * M + pr) * 4 + h]; ovn[g] = *(const u32x2*)(R1 + (size_t)(T_CQ + g) * TILE_E + pr * 256 + 4 * lane); } }
    for (int m = gw; m < M; m += NGW) {
        float ls[3]; u32x2 ov[3];
#pragma unroll
        for (int g = 0; g < 3; ++g) { ls[g] = lsn[g]; ov[g] = ovn[g]; }
        if (m + NGW < M) {
#pragma unroll
            for (int g = 0; g < 3; ++g) { const size_t pr = (size_t)pg8::perm_row(m + NGW, 2 * g); lsn[g] = lse[((size_t)g * M + pr) * 4 + h]; ovn[g] = *(const u32x2*)(R1 + (size_t)(T_CQ + g) * TILE_E + pr * 256 + 4 * lane); } }
        const float mx = fmaxf(fmaxf(ls[0], ls[1]), ls[2]);
        float w[3]; float ws = 0.f;
#pragma unroll
        for (int g = 0; g < 3; ++g) { w[g] = fast_exp2(ls[g] - mx); ws += w[g]; }
        const float iw = 1.0f / ws; float o0 = 0.f, o1 = 0.f, o2 = 0.f, o3 = 0.f;
#pragma unroll
        for (int g = 0; g < 3; ++g) { const float wg = w[g] * iw; o0 += wg * bflo(ov[g].x); o1 += wg * bfhi(ov[g].x); o2 += wg * bflo(ov[g].y); o3 += wg * bfhi(ov[g].y); }
        *(u32x2*)(OB + (size_t)m * 1024 + 512 + 4 * lane) = (u32x2){cvt_pk_bf16(o0, o1), cvt_pk_bf16(o2, o3)};
    }
}
constexpr int LN_ROUTE_OFF = LDS_AUX;
template <bool XBF> __device__ __forceinline__ void ln1_phase(Frame& F, const Args& a, int l, const void* xin_, bf16_t* x1out, const bf16_t* y, bf16_t* vout) {
    const float* xin = (const float*)xin_; const bf16_t* xinb = (const bf16_t*)xin_;
    const int tid = F.tid_(), lane = tid & 63, wid = F.wave;
    LAS float* wrt = (LAS float*)(F.lds + LDS_BIG);
    LAS unsigned* re = (LAS unsigned*)(F.lds + LN_ROUTE_OFF); LAS float* rw = (LAS float*)(F.lds + LN_ROUTE_OFF + 1024); LAS unsigned* lbase = (LAS unsigned*)(F.lds + LN_ROUTE_OFF + 2048);
    {   float t_[32];
#pragma unroll
        for (int k = 0; k < 32; ++k) { const int i = tid + k * NTHREADS; t_[k] = a.in[IN_WROUTER][(i & 1023) * 16 + (i >> 10)]; }
#pragma unroll
        for (int k = 0; k < 32; ++k) wrt[tid + k * NTHREADS] = t_[k]; }
    __syncthreads();
    const float* modl = (const float*)(F.ws + WS_MOD) + (size_t)l * 4 * 6144;
    const float* lg = a.in[IN_LN1G] + l * D; const float* lb = a.in[IN_LN1B] + l * D;
    unsigned* liste = (unsigned*)(F.ws + WS_LISTE); float* listw = (float*)(F.ws + WS_LISTW);
    gu32* ecnt = F.ctl + CW_ECNT + 1024 * l;
    for (int chunk = F.vcu; chunk < M / 128; chunk += F.G) {
        f32x4 ga1[4], lgv[4], lbv[4], sc1[4], shv[4];
        const int eL = ((lane & 1) << 3) | ((lane & 2) << 1) | ((lane & 4) >> 1) | ((lane & 8) >> 3), gL = eL >> 2;
        const float brtl = a.in[IN_BROUTER][eL];
        { const float* mbc = modl + (size_t)((chunk * 128) >> 13) * 6144;
#pragma unroll
          for (int j = 0; j < 4; ++j) { const int c = 4 * lane + 256 * j; ga1[j] = *(const f32x4*)(mbc + 2 * D + c); lgv[j] = *(const f32x4*)(lg + c); lbv[j] = *(const f32x4*)(lb + c);
              sc1[j] = *(const f32x4*)(mbc + 4 * D + c); shv[j] = *(const f32x4*)(mbc + 3 * D + c); }
          __builtin_amdgcn_sched_barrier(0);
#pragma unroll
          for (int j = 0; j < 4; ++j) { ga1[j] = ga1[j] + 1.0f; sc1[j] = sc1[j] + 1.0f; } }
        f32x4 xn[4]; u32x2 xnb[4]; u32x2 yn[4];
        { const int m0 = chunk * 128 + wid * 16;
#pragma unroll
          for (int j = 0; j < 4; ++j) { const int c = 4 * lane + 256 * j; if constexpr (XBF) xnb[j] = *(const u32x2*)(xinb + (size_t)m0 * D + c); else xn[j] = *(const f32x4*)(xin + (size_t)m0 * D + c);
              yn[j] = *(const u32x2*)(y + (size_t)m0 * D + c); } }
        for (int i = 0; i < 16; ++i) {
            const int rl = wid * 16 + i, m = chunk * 128 + rl;
            f32x4 z[4]; float s = 0.f;
#pragma unroll
            for (int j = 0; j < 4; ++j) { f32x4 xv; if constexpr (XBF) xv = (f32x4){bflo(xnb[j].x), bfhi(xnb[j].x), bflo(xnb[j].y), bfhi(xnb[j].y)}; else xv = xn[j];
                const u32x2 yv = yn[j];
                z[j] = xv * ALPHA + ga1[j] * (f32x4){bflo(yv.x), bfhi(yv.x), bflo(yv.y), bfhi(yv.y)}; s += (z[j][0] + z[j][1]) + (z[j][2] + z[j][3]); }
            if (i + 1 < 16) {
#pragma unroll
                for (int j = 0; j < 4; ++j) { const int c = 4 * lane + 256 * j; if constexpr (XBF) xnb[j] = *(const u32x2*)(xinb + (size_t)(m + 1) * D + c); else xn[j] = *(const f32x4*)(xin + (size_t)(m + 1) * D + c);
                    yn[j] = *(const u32x2*)(y + (size_t)(m + 1) * D + c); } }
            const float mean = wave_sum(s) * (1.f / D); float s2 = 0.f;
#pragma unroll
            for (int j = 0; j < 4; ++j) { z[j] = z[j] - mean; s2 += (z[j][0] * z[j][0] + z[j][1] * z[j][1]) + (z[j][2] * z[j][2] + z[j][3] * z[j][3]); }
            const float rstd = rsqrtf(wave_sum(s2) * (1.f / D) + LN_EPS);
            float lgt[16];
#pragma unroll
            for (int e = 0; e < 16; ++e) lgt[e] = 0.f;
#pragma unroll
            for (int j = 0; j < 4; ++j) { const int c = 4 * lane + 256 * j;
                const f32x4 x1 = z[j] * rstd * lgv[j] + lbv[j];
                *(u32x2*)(x1out + (size_t)m * D + c) = (u32x2){cvt_pk_bf16(x1[0], x1[1]), cvt_pk_bf16(x1[2], x1[3])};
                const f32x4 v = x1 * sc1[j] + shv[j];
                *(u32x2*)(vout + (size_t)m * D + c) = (u32x2){cvt_pk_bf16(v[0], v[1]), cvt_pk_bf16(v[2], v[3])};
                f32x4 wv[16];
#pragma unroll
                for (int e = 0; e < 16; ++e) wv[e] = *(const LAS f32x4*)(wrt + e * 1024 + c);
                __builtin_amdgcn_sched_barrier(0);
#pragma unroll
                for (int e = 0; e < 16; ++e) lgt[e] = __builtin_fmaf(v[0], wv[e][0], __builtin_fmaf(v[1], wv[e][1], __builtin_fmaf(v[2], wv[e][2], __builtin_fmaf(v[3], wv[e][3], lgt[e])))); }
            float r1[8], r2[4], r3[2], r4;
            { const bool b0 = lane & 1, b1 = lane & 2, b2 = lane & 4, b3 = lane & 8;
#pragma unroll
              for (int j = 0; j < 8; ++j) { const float snd = b0 ? lgt[j] : lgt[j + 8], kp = b0 ? lgt[j + 8] : lgt[j]; r1[j] = kp + swz_xor<1>(snd); }
#pragma unroll
              for (int j = 0; j < 4; ++j) { const float snd = b1 ? r1[j] : r1[j + 4], kp = b1 ? r1[j + 4] : r1[j]; r2[j] = kp + swz_xor<2>(snd); }
#pragma unroll
              for (int j = 0; j < 2; ++j) { const float snd = b2 ? r2[j] : r2[j + 2], kp = b2 ? r2[j + 2] : r2[j]; r3[j] = kp + swz_xor<4>(snd); }
              { const float snd = b3 ? r3[0] : r3[1], kp = b3 ? r3[1] : r3[0]; r4 = kp + swz_xor<8>(snd); }
              r4 += swz_xor<16>(r4);
              auto rr = __builtin_amdgcn_permlane32_swap(__float_as_uint(r4), __float_as_uint(r4), false, false); r4 = __uint_as_float(rr[0]) + __uint_as_float(rr[1]); }
            float mxl = fmaxf(r4, swz_xor<1>(r4)); mxl = fmaxf(mxl, swz_xor<2>(mxl)); mxl = fmaxf(mxl, swz_xor<4>(mxl)); mxl = fmaxf(mxl, swz_xor<8>(mxl));
            const float pe = __expf(r4 - mxl);
            float ps = pe + swz_xor<1>(pe); ps += swz_xor<2>(ps); ps += swz_xor<4>(ps); ps += swz_xor<8>(ps);
            const float prl = pe * (1.0f / ps), sll = prl + brtl;
            const float sb = swz_xor<4>(sll), sc_ = swz_xor<8>(sll), sd = swz_xor<8>(sb);
            const float hi1 = fmaxf(sll, sb), lo1 = fminf(sll, sb), hi2 = fmaxf(sc_, sd), lo2 = fminf(sc_, sd);
            float bgs = fmaxf(hi1, hi2) + fmaxf(fminf(hi1, hi2), fmaxf(lo1, lo2)); int bg = gL;
            { const float og = swz_xor<1>(bgs); const int oi = __builtin_amdgcn_update_dpp(0, bg, 0xB1, 0xf, 0xf, false); const bool tk = (og > bgs) || (og == bgs && oi < bg); bgs = tk ? og : bgs; bg = tk ? oi : bg; }
            { const float og = swz_xor<2>(bgs); const int oi = __builtin_amdgcn_update_dpp(0, bg, 0x4E, 0xf, 0xf, false); const bool tk = (og > bgs) || (og == bgs && oi < bg); bgs = tk ? og : bgs; bg = tk ? oi : bg; }
            const int rk = (int)((sb > sll) || (sb == sll && (eL ^ 2) < eL)) + (int)((sc_ > sll) || (sc_ == sll && (eL ^ 1) < eL)) + (int)((sd > sll) || (sd == sll && (eL ^ 3) < eL));
            const bool ing = (lane < 16) && (gL == bg);
            const unsigned long long m0 = __ballot(ing && rk == 0), m1 = __ballot(ing && rk == 1);
            const int l0 = m0 ? (int)__builtin_ctzll(m0) : 0, l1 = m1 ? (int)__builtin_ctzll(m1) : 0;
            const int e0 = __builtin_amdgcn_readlane(eL, l0), e1 = __builtin_amdgcn_readlane(eL, l1);
            const float p0 = __uint_as_float((unsigned)__builtin_amdgcn_readlane((int)__float_as_uint(prl), l0)), p1 = __uint_as_float((unsigned)__builtin_amdgcn_readlane((int)__float_as_uint(prl), l1));
            const float inv = 1.0f / (p0 + p1);
            if (lane == 0) { re[2 * rl] = (unsigned)e0; re[2 * rl + 1] = (unsigned)e1; rw[2 * rl] = p0 * inv; rw[2 * rl + 1] = p1 * inv; }
        }
        __syncthreads();
        LAS unsigned* wcnt = lbase + 16; LAS unsigned* wbase = lbase + 80;
        unsigned ee = 0u, rk = 0u;
        if (wid < 4) { ee = re[tid];
#pragma unroll
            for (int x = 0; x < 16; ++x) { const unsigned long long bm = __ballot(ee == (unsigned)x);
                const unsigned below = __builtin_amdgcn_mbcnt_hi((unsigned)(bm >> 32), __builtin_amdgcn_mbcnt_lo((unsigned)bm, 0u));
                rk = (ee == (unsigned)x) ? below : rk;
                if (lane == 0) wcnt[wid * 16 + x] = (unsigned)__builtin_popcountll(bm); } }
        __syncthreads();
        if (tid < 16) { const unsigned c0 = wcnt[tid], c1 = wcnt[16 + tid], c2 = wcnt[32 + tid], c3 = wcnt[48 + tid], c = c0 + c1 + c2 + c3;
            const unsigned base = c ? __hip_atomic_fetch_add(ecnt + 64 * tid, c, RLX_AGENT) : 0u;
            wbase[tid] = base; wbase[16 + tid] = base + c0; wbase[32 + tid] = base + c0 + c1; wbase[48 + tid] = base + c0 + c1 + c2; }
        __syncthreads();
        if (wid < 4) { const unsigned pos = wbase[wid * 16 + ee] + rk; const unsigned tok = (unsigned)(chunk * 128 + (tid >> 1));
            if (pos < 32768u) { liste[(size_t)ee * 32768 + pos] = tok * 2u + (unsigned)(tid & 1); listw[(size_t)ee * 32768 + pos] = rw[tid]; } }
        __syncthreads();
    }
}
template <bool LAST> __device__ __forceinline__ void ln2_phase(Frame& F, const Args& a, int l, const bf16_t* x, float* xf, bf16_t* xb, const bf16_t* y0, const bf16_t* y1, bf16_t* unext_) {
    bf16_t* unext = LAST ? nullptr : unext_;
    const int lane = F.lane_(); const int gw = F.vcu * NWAVES + F.wave, NGW = F.G * NWAVES;
    const float* modl = (const float*)(F.ws + WS_MOD) + (size_t)l * 4 * 6144;
    const float* lg = a.in[IN_LN2G] + l * D; const float* lb = a.in[IN_LN2B] + l * D;
    constexpr int RPW = 16;
    for (int chunk = gw; chunk < M / RPW; chunk += NGW) {
    const int m0 = chunk * RPW; const int b = m0 >> 13; const float* mb = modl + (size_t)b * 6144; const float* mn = mb + 4 * 6144;
    f32x4 lgv[4], lbv[4], g1[4], sc1[4], shv[4];
#pragma unroll
    for (int j = 0; j < 4; ++j) { const int c = 4 * lane + 256 * j; lgv[j] = *(const f32x4*)(lg + c); lbv[j] = *(const f32x4*)(lb + c); g1[j] = *(const f32x4*)(mb + 5 * D + c); sc1[j] = f32x4{}; shv[j] = f32x4{}; }
    if (unext) {
#pragma unroll
        for (int j = 0; j < 4; ++j) { const int c = 4 * lane + 256 * j; sc1[j] = *(const f32x4*)(mn + D + c); shv[j] = *(const f32x4*)(mn + c); } }
    u32x2 xA[4], yaA[4], ybA[4], xB[4], yaB[4], ybB[4];
#pragma unroll
    for (int j = 0; j < 4; ++j) { const int c = 4 * lane + 256 * j; xA[j] = *(const u32x2*)(x + (size_t)m0 * D + c); yaA[j] = *(const u32x2*)(y0 + (size_t)m0 * D + c); ybA[j] = *(const u32x2*)(y1 + (size_t)m0 * D + c);
        xB[j] = *(const u32x2*)(x + (size_t)(m0 + 1) * D + c); yaB[j] = *(const u32x2*)(y0 + (size_t)(m0 + 1) * D + c); ybB[j] = *(const u32x2*)(y1 + (size_t)(m0 + 1) * D + c); }
    __builtin_amdgcn_sched_barrier(0);
#pragma unroll
    for (int j = 0; j < 4; ++j) { g1[j] = g1[j] + 1.0f; sc1[j] = sc1[j] + 1.0f; }
    auto row = [&](const int i, u32x2 (&xn)[4], u32x2 (&yan)[4], u32x2 (&ybn)[4]) __attribute__((always_inline)) {
        const int m = m0 + i;
        f32x4 z[4]; float s = 0.f;
#pragma unroll
        for (int j = 0; j < 4; ++j) { const f32x4 xv = (f32x4){bflo(xn[j].x), bfhi(xn[j].x), bflo(xn[j].y), bfhi(xn[j].y)};
            const u32x2 ya = yan[j], yb = ybn[j];
            const f32x4 yy = (f32x4){bflo(ya.x) + bflo(yb.x), bfhi(ya.x) + bfhi(yb.x), bflo(ya.y) + bflo(yb.y), bfhi(ya.y) + bfhi(yb.y)};
            z[j] = xv * ALPHA + g1[j] * yy; s += (z[j][0] + z[j][1]) + (z[j][2] + z[j][3]); }
        if (i + 2 < RPW) { const size_t mn_ = (size_t)(m + 2);
#pragma unroll
            for (int j = 0; j < 4; ++j) { const int c = 4 * lane + 256 * j; xn[j] = *(const u32x2*)(x + mn_ * D + c); yan[j] = *(const u32x2*)(y0 + mn_ * D + c); ybn[j] = *(const u32x2*)(y1 + mn_ * D + c); } }
        const float mean = wave_sum(s) * (1.f / D); float s2 = 0.f;
#pragma unroll
        for (int j = 0; j < 4; ++j) { z[j] = z[j] - mean; s2 += (z[j][0] * z[j][0] + z[j][1] * z[j][1]) + (z[j][2] * z[j][2] + z[j][3] * z[j][3]); }
        const float rstd = rsqrtf(wave_sum(s2) * (1.f / D) + LN_EPS);
#pragma unroll
        for (int j = 0; j < 4; ++j) { const int c = 4 * lane + 256 * j;
            const f32x4 x2 = z[j] * rstd * lgv[j] + lbv[j];
            if constexpr (LAST) *(f32x4*)(xf + (size_t)m * D + c) = x2; else *(u32x2*)(xb + (size_t)m * D + c) = (u32x2){cvt_pk_bf16(x2[0], x2[1]), cvt_pk_bf16(x2[2], x2[3])};
            if (unext) { const f32x4 u = x2 * sc1[j] + shv[j];
                *(u32x2*)(unext + (size_t)m * D + c) = (u32x2){cvt_pk_bf16(u[0], u[1]), cvt_pk_bf16(u[2], u[3])}; } }
    };
    for (int i = 0; i < RPW; i += 2) { row(i, xA, yaA, ybA); row(i + 1, xB, yaB, ybB); }
    }
}

#if defined(__HIP_DEVICE_COMPILE__)
#define NO_PK_F32 __attribute__((target("no-packed-fp32-ops")))
#else
#define NO_PK_F32
#endif
__global__ void __launch_bounds__(NTHREADS, 2) NO_PK_F32 fwd_kernel(Args args) {
    extern __shared__ __attribute__((aligned(16))) unsigned char lds_raw[];
    Frame F;
    F.lds = (LAS unsigned char*)lds_raw;
    F.wave = __builtin_amdgcn_readfirstlane((int)threadIdx.x >> 6);
    F.G = gridDim.x; { const int bx = blockIdx.x; F.vcu = (F.G % 8 == 0) ? (bx % 8) * (F.G / 8) + bx / 8 : bx; }
    typedef __attribute__((address_space(4))) const Args CArgs;
    CArgs* AP = (CArgs*)__builtin_amdgcn_kernarg_segment_ptr();
#define ARGS (*(const Args*)AP)
    F.ws = ARGS.ws; F.ctl = (gu32*)(F.ws + WS_CTL);
    volatile LAS unsigned* MISC = (volatile LAS unsigned*)(F.lds + LDS_MISC);
    for (int u = F.tid_(); u < (LDS_BYTES - LDS_MISC) / 4; u += NTHREADS) ((LAS unsigned*)(F.lds + LDS_MISC))[u] = 0u;
    __syncthreads();
    const int lo = ARGS.ph_lo, hi = ARGS.ph_hi;
    const bool multi = (hi - lo) > 1;
    XcdBarrier bar; bar.bar = (unsigned*)(F.ctl + CW_BAR); bar.x = 0; bar.st = nullptr;
    if (multi) bar = xcd_barrier_post((unsigned*)(F.ctl + CW_BAR), MISC + MISC_BARW);
#define IN(k) (lo <= (k) && (k) < hi && (F.ws = (unsigned char*)launder_s((GAS unsigned char*)F.ws), F.ctl = (gu32*)F.ws, F.vcu = launder_si(F.vcu), F.wave = launder_si(F.wave), F.G = launder_si(F.G), AP = launder_s(AP), true))
#define SEAM(k) do { if (IN((k) + 1)) xcd_barrier(bar); } while (0)
#define UBUF ((bf16_t*)(F.ws + WS_UBUF))
#define R1 ((bf16_t*)(F.ws + WS_R1))
#define OBUF ((bf16_t*)(F.ws + WS_OBUF))
#define mod ((const float*)(F.ws + WS_MOD))

    if (IN(0)) { p0_prologue(F, ARGS); SEAM(0); }
    for (int l = 0; l < DEPTH; ++l) {
        const int pb = 1 + PPL * l;
        const float* modl = mod + (size_t)l * 4 * 6144;
        if (l == 0 && IN(pb + 0)) { modulate_rows(F, ARGS.in[IN_X], modl, 0, 1, UBUF); SEAM(pb + 0); }
        if (IN(pb + 1)) {
            pg8::FullOrder S; S.init(UBUF, D, (const bf16_t*)(F.ws + WS_WIN) + (size_t)l * NWIN * D, D, M, NPT * 256, F.G, (int)blockIdx.x);
            pg8::EpiInproj E{R1, (bf16_t*)(F.ws + WS_IKC)};
            pg8::gemm_phase<pg8::EpiInproj, pg8::FullOrder, false, false>(F.lds + LDS_BIG, S, E, F.wave);
            SEAM(pb + 1);
        }
        if (IN(pb + 2)) { attention_phase(F, ARGS, l); SEAM(pb + 2); }
        if (IN(pb + 3)) { combine_c(F); SEAM(pb + 3); }
        if (IN(pb + 4)) {
            pg8::FullOrder S; S.init(UBUF, D, (const bf16_t*)(F.ws + WS_WIN) + ((size_t)l * NWIN + NPT * 256) * D, D, M, NGT * 256, F.G, (int)blockIdx.x);
            pg8::EpiGate E{R1};
            pg8::gemm_phase<pg8::EpiGate, pg8::FullOrder, false, false>(F.lds + LDS_BIG, S, E, F.wave);
            SEAM(pb + 4);
        }
        if (IN(pb + 5)) {
            pg8::MergeOrderH S; S.fo.init(OBUF, 1024, nullptr, 256, M, 2 * D, F.G, (int)blockIdx.x); S.Wb = (const char*)((const bf16_t*)(F.ws + WS_WB) + (size_t)l * 4 * D * 256); S.K = 256; S.lda = 1024;
            pg8::EpiMergeH E{R1, UBUF};
            pg8::gemm_phase<pg8::EpiMergeH, pg8::MergeOrderH, false, false, true>(F.lds + LDS_BIG, S, E, F.wave);
            SEAM(pb + 5);
        }
        if (IN(pb + 6)) {
            pg8::FullOrder S; S.init(UBUF, D, (const bf16_t*)(F.ws + WS_WO) + (size_t)l * D * D, D, M, D, F.G, (int)blockIdx.x);
            pg8::EpiPlain E{OBUF, D};
            pg8::gemm_phase<pg8::EpiPlain, pg8::FullOrder, false, false>(F.lds + LDS_BIG, S, E, F.wave);
            SEAM(pb + 6);
        }
        if (IN(pb + 7)) { if (l == 0) ln1_phase<false>(F, ARGS, l, ARGS.in[IN_X], OBUF, OBUF, UBUF); else ln1_phase<true>(F, ARGS, l, ARGS.out, OBUF, OBUF, UBUF); SEAM(pb + 7); }
        if (IN(pb + 8)) {
            pg8::MoeOrder S; S.init(F.ctl + CW_ECNT + 1024 * l, 2, F.G, F.vcu); S.A = (const char*)UBUF; S.lda = 0; S.K = D; S.W = (const char*)((const bf16_t*)(F.ws + WS_W1) + (size_t)l * 16 * 512 * D); S.wstride = (size_t)512 * D * 2;
            S.liste = (const unsigned*)(F.ws + WS_LISTE);
            pg8::EpiMoe1 E{(bf16_t*)(F.ws + WS_R1 + R1_H)};
            pg8::gemm_phase<pg8::EpiMoe1, pg8::MoeOrder, true, true>(F.lds + LDS_BIG, S, E, F.wave);
            SEAM(pb + 8);
        }
        if (IN(pb + 9)) {
            pg8::MoeOrder S; S.init(F.ctl + CW_ECNT + 1024 * l, 4, F.G, F.vcu); S.A = (const char*)(F.ws + WS_R1 + R1_H); S.lda = 256; S.K = 256; S.W = (const char*)((const bf16_t*)(F.ws + WS_W2) + (size_t)l * 16 * D * 256); S.wstride = (size_t)D * 256 * 2;
            S.liste = (const unsigned*)(F.ws + WS_LISTE);
            pg8::EpiMoe2 E{(bf16_t*)(F.ws + WS_R1 + R1_Y0), (bf16_t*)(F.ws + WS_R1 + R1_Y1), (const unsigned*)(F.ws + WS_LISTE), (const float*)(F.ws + WS_LISTW)};
            pg8::gemm_phase<pg8::EpiMoe2, pg8::MoeOrder, true, false>(F.lds + LDS_BIG, S, E, F.wave);
            SEAM(pb + 9);
        }
        if (IN(pb + 10)) { const bf16_t* y0p = (const bf16_t*)(F.ws + WS_R1 + R1_Y0); const bf16_t* y1p = (const bf16_t*)(F.ws + WS_R1 + R1_Y1);
            if (l + 1 < DEPTH) ln2_phase<false>(F, ARGS, l, OBUF, nullptr, (bf16_t*)ARGS.out, y0p, y1p, UBUF); else ln2_phase<true>(F, ARGS, l, OBUF, ARGS.out, nullptr, y0p, y1p, nullptr);
            if (pb + 10 + 1 < N_PHASES) SEAM(pb + 10); }
    }
#undef IN
#undef SEAM
#undef ARGS
#undef UBUF
#undef R1
#undef OBUF
#undef mod
}

#if DBG
__device__ __forceinline__ void rms_acc(unsigned* errw, int id, float got, float ref) { atomicAdd((float*)errw + 64 + 2 * id, (got - ref) * (got - ref)); atomicAdd((float*)errw + 65 + 2 * id, ref * ref); }
__device__ __forceinline__ void err_max(unsigned* errw, int id, float e) { if (!(e == e)) e = 1e30f; if (e < 0.f) e = 0.f; atomicMax(errw + id, __float_as_uint(e)); }
__device__ __forceinline__ unsigned hash_u32(unsigned x) { x ^= x >> 16; x *= 0x7feb352du; x ^= x >> 15; x *= 0x846ca68bu; x ^= x >> 16; return x; }
__device__ __forceinline__ void inproj_loc(int j, int& pn, int& c, float& sc, int& lg) {
    sc = 1.f; lg = 0;
    if (j < 256) { pn = T_AQ; c = j; sc = SC32; }
    else if (j < 512) { pn = T_AK; c = j - 256; }
    else if (j < 768) { pn = T_AV; c = j - 512; }
    else if (j < 1024) { pn = T_BQ; c = j - 768; sc = SC64; }
    else if (j < 1152) { pn = T_BKV; c = j - 1024; }
    else if (j < 1280) { pn = T_BKV; c = 128 + j - 1152; }
    else if (j < 2048) { const int g = (j - 1280) / 256; pn = T_CQ + g; c = (j - 1280) % 256; sc = SC64; lg = 2 * g; }
    else if (j < 2816) { const int g = (j - 2048) / 256; pn = T_CK + g; c = (j - 2048) % 256; lg = 2 * g; }
    else if (j < 3584) { const int g = (j - 2816) / 256; pn = T_CV + g; c = (j - 2816) % 256; lg = 2 * g; }
    else if (j < 3840) { pn = T_DQ; c = j - 3584; sc = SC64; }
    else if (j < 3904) { pn = T_MISC; c = j - 3840; }
    else if (j < 3968) { pn = T_MISC; c = 64 + j - 3904; }
    else if (j < 4224) { pn = T_IQ; c = j - 3968; }
    else if (j < 4256) { pn = T_MISC; c = 128 + j - 4224; }
    else if (j < 4264) { pn = T_MISC; c = 160 + j - 4256; }
    else { pn = (j - 4264) / 256; c = (j - 4264) % 256; }
}
__global__ void chk_mod(Args a, int l) {
    unsigned* errw = (unsigned*)(a.ws + WS_CTL) + CW_ERR;
    const int s = blockIdx.x * blockDim.x + threadIdx.x; if (s >= 512) return;
    const unsigned h = hash_u32(s * 7919u + 13u + l); const int b = h & 3, j = (h >> 2) % 6144;
    float r = a.in[IN_BADA][(size_t)l * 6144 + j];
    for (int k = 0; k < D; ++k) { const float cv = a.in[IN_C][b * D + k]; r += (cv / (1.f + expf(-cv))) * a.in[IN_WADA][((size_t)l * D + k) * 6144 + j]; }
    const float got = ((const float*)(a.ws + WS_MOD))[((size_t)l * 4 + b) * 6144 + j];
    err_max(errw, 11, fabsf(got - r) / (1e-4f + 1e-3f * fabsf(r)));
}
__global__ void chk_u(Args a, int l, const float* xin) {
    unsigned* errw = (unsigned*)(a.ws + WS_CTL) + CW_ERR;
    const int s = blockIdx.x * blockDim.x + threadIdx.x; if (s >= 4096) return;
    const unsigned h = hash_u32(s * 7919u + 17u); const int m = h % M, c = (h >> 15) % D, b = m >> 13;
    const float* modl = (const float*)(a.ws + WS_MOD) + ((size_t)l * 4 + b) * 6144;
    const float r = xin[(size_t)m * D + c] * (1.f + modl[D + c]) + modl[c];
    const float got = bf2f(((const bf16_t*)(a.ws + WS_UBUF))[(size_t)m * D + c]);
    err_max(errw, 12, fabsf(got - r) / (0.01f + 0.01f * fabsf(r)));
}
__global__ void chk_inproj(Args a, int l, int gates) {
    unsigned* errw = (unsigned*)(a.ws + WS_CTL) + CW_ERR;
    const int s = blockIdx.x * (blockDim.x >> 6) + (threadIdx.x >> 6), lane = threadIdx.x & 63; if (s >= 2048) return;
    const unsigned h = hash_u32(s * 104729u + 31u + gates); const int m = h % M; const int j = gates ? 4264 + (int)((h >> 15) % 4096) : (int)((h >> 15) % 4264);
    const bf16_t* u = (const bf16_t*)(a.ws + WS_UBUF) + (size_t)m * D; const float* w = a.in[IN_WIN] + (size_t)l * D * INW + j;
    float r = 0.f; for (int k = lane; k < D; k += 64) r += bf2f(u[k]) * w[(size_t)k * INW];
    r = wave_sum(r);
    int pn, c, lg; float sc; inproj_loc(j, pn, c, sc, lg);
    const int prow = pg8::perm_row(m, lg);
    float got = bf2f(((const bf16_t*)(a.ws + WS_R1))[(size_t)pn * TILE_E + (size_t)prow * 256 + c]);
    if (gates) r = 1.f / (1.f + expf(-r)); else got /= sc;
    if (lane == 0) { rms_acc(errw, gates ? 20 : 13, got, r); err_max(errw, gates ? 20 : 13, fabsf(got - r) / (0.03f + 0.02f * fabsf(r))); }
}

__device__ __forceinline__ float bias2(const float* rel, int dist, int head) { return rel[t5_bucket(dist) * NBH + head] * LOG2E; }
template <int type> __global__ void __launch_bounds__(64) chk_attn_ab(Args a, int l) {
    unsigned* errw = (unsigned*)(a.ws + WS_CTL) + CW_ERR;
    const bf16_t* R1 = (const bf16_t*)(a.ws + WS_R1); const bf16_t* OB = (const bf16_t*)(a.ws + WS_OBUF);
    const int lane = threadIdx.x; const unsigned hs = hash_u32(blockIdx.x * 2654435761u + 77u + type);
    const int b = hs & 3, h = (hs >> 2) & 3; int t = (hs >> 4) & (SEQ - 1); if (blockIdx.x < 4) t = blockIdx.x * 37; if (blockIdx.x == 4) t = SEQ - 1;
    const long row = (long)b * SEQ + t; const float* rel = a.in[IN_REL];
    constexpr int nmap = type == 0 ? 2 : 1, qd = type == 0 ? 32 : 64;
    const bf16_t* qp = R1 + (size_t)(type == 0 ? T_AQ : T_BQ) * TILE_E + row * 256 + h * 64;
    const bf16_t* kb = type == 0 ? R1 + (size_t)T_AK * TILE_E + h * 64 : R1 + (size_t)T_BKV * TILE_E + (h >> 1) * 64;
    const bf16_t* vbp = type == 0 ? R1 + (size_t)T_AV * TILE_E + h * 64 : R1 + (size_t)T_BKV * TILE_E + 128 + (h >> 1) * 64;
    float q[64];
#pragma unroll
    for (int d = 0; d < 64; ++d) q[d] = bf2f(qp[d]);
    const int klo = type == 0 ? 0 : (t - 127 > 0 ? t - 127 : 0);
    float mx[2] = {-1e30f, -1e30f};
    for (int k = klo + lane; k <= t; k += 64) { const bf16_t* kr = kb + ((long)b * SEQ + k) * 256; const float bs = bias2(rel, t - k, (type == 0 ? 0 : 4) + h);
        _Pragma("unroll") for (int m = 0; m < nmap; ++m) { float s = 0.f; _Pragma("unroll") for (int d = 0; d < qd; ++d) s += q[m * 32 + d] * bf2f(kr[m * 32 + d]); s += bs; mx[m] = fmaxf(mx[m], s); } }
    for (int m = 0; m < 2; ++m) for (int o = 1; o < 64; o <<= 1) mx[m] = fmaxf(mx[m], __shfl_xor(mx[m], o));
    float ls[2] = {0.f, 0.f}; float acc[2][64];
#pragma unroll
    for (int m = 0; m < 2; ++m)
#pragma unroll
        for (int d = 0; d < 64; ++d) acc[m][d] = 0.f;
    for (int k = klo + lane; k <= t; k += 64) { const bf16_t* kr = kb + ((long)b * SEQ + k) * 256; const bf16_t* vr = vbp + ((long)b * SEQ + k) * 256; const float bs = bias2(rel, t - k, (type == 0 ? 0 : 4) + h);
        float p[2] = {0.f, 0.f};
        _Pragma("unroll") for (int m = 0; m < nmap; ++m) { float s = 0.f; _Pragma("unroll") for (int d = 0; d < qd; ++d) s += q[m * 32 + d] * bf2f(kr[m * 32 + d]); s += bs; p[m] = exp2f(s - mx[m]); ls[m] += p[m]; }
        _Pragma("unroll") for (int d = 0; d < 64; ++d) { const float v = bf2f(vr[d]); acc[0][d] += p[0] * v; if (nmap == 2) acc[1][d] += p[1] * v; } }
    for (int m = 0; m < 2; ++m) ls[m] = wave_sum(ls[m]);
    float mine = 0.f;
#pragma unroll
    for (int d = 0; d < 64; ++d) { const float a0 = wave_sum(acc[0][d]), a1 = nmap == 2 ? wave_sum(acc[1][d]) : 0.f; float v;
        if (type == 0) v = a0 / ls[0] - ((const float*)(a.ws + WS_LAM))[l] * a1 / ls[1]; else v = a0 / (ls[0] + exp2f(a.in[IN_SINKS][l * 4 + h] * LOG2E - mx[0]));
        if (d == lane) mine = v; }
    if (type == 0) { const float ss = wave_sum(mine * mine); mine = mine * rsqrtf(ss / 64.f + 1e-5f) * a.in[IN_SUBLN][l * 64 + lane] * (1.f - ((const float*)(a.ws + WS_LAM))[2 + l]); }
    const float got = bf2f(OB[row * 1024 + (type == 0 ? 0 : 256) + h * 64 + lane]);
    float e = fabsf(got - mine) / (0.02f + 0.03f * fabsf(mine));
    rms_acc(errw, type == 0 ? 14 : 15, got, mine);
    for (int o = 1; o < 64; o <<= 1) e = fmaxf(e, __shfl_xor(e, o));
    if (lane == 0) err_max(errw, type == 0 ? 14 : 15, e);
}
__global__ void __launch_bounds__(64) chk_attn_c(Args a, int l) {
    unsigned* errw = (unsigned*)(a.ws + WS_CTL) + CW_ERR;
    const bf16_t* R1 = (const bf16_t*)(a.ws + WS_R1);
    const int lane = threadIdx.x; const unsigned hs = hash_u32(blockIdx.x * 2654435761u + 991u);
    const int b = hs & 3, h = (hs >> 2) & 3, g = (hs >> 4) % 3; int t = (hs >> 8) & (SEQ - 1); if (blockIdx.x < 6) t = blockIdx.x * 53;
    const int lg = 2 * g, r = 1 << lg; const long row = (long)b * SEQ + t; const float* rel = a.in[IN_REL];
    float qv = 0.f; { const bf16_t* u = (const bf16_t*)(a.ws + WS_UBUF) + row * D; const float* w = a.in[IN_WIN] + (size_t)l * D * INW + 1280 + g * 256 + h * 64 + lane;
        for (int k = 0; k < D; ++k) qv += bf2f(u[k]) * w[(size_t)k * INW]; qv = bf2f(f2bf(qv * SC64)); }
    float q[64]; _Pragma("unroll") for (int d = 0; d < 64; ++d) q[d] = __shfl(qv, d);
    const bf16_t* kb = R1 + (size_t)(T_CK + g) * TILE_E + h * 64; const bf16_t* vbp = R1 + (size_t)(T_CV + g) * TILE_E + h * 64;
    float mx = -1e30f;
    for (int j = lane; j <= 128; j += 64) { const int kt = t - r * j; if (kt < 0) continue; const bf16_t* kr = kb + (long)pg8::perm_row((int)((long)b * SEQ + kt), lg) * 256;
        float s = 0.f; _Pragma("unroll") for (int d = 0; d < 64; ++d) s += q[d] * bf2f(kr[d]); s += bias2(rel, r * j, 8 + 4 * g + h); mx = fmaxf(mx, s); }
    for (int o = 1; o < 64; o <<= 1) mx = fmaxf(mx, __shfl_xor(mx, o));
    float ls = 0.f; float acc[64]; _Pragma("unroll") for (int d = 0; d < 64; ++d) acc[d] = 0.f;
    for (int j = lane; j <= 128; j += 64) { const int kt = t - r * j; if (kt < 0) continue; const long pr = pg8::perm_row((int)((long)b * SEQ + kt), lg); const bf16_t* kr = kb + pr * 256; const bf16_t* vr = vbp + pr * 256;
        float s = 0.f; _Pragma("unroll") for (int d = 0; d < 64; ++d) s += q[d] * bf2f(kr[d]); s += bias2(rel, r * j, 8 + 4 * g + h); const float p = exp2f(s - mx); ls += p;
        _Pragma("unroll") for (int d = 0; d < 64; ++d) acc[d] += p * bf2f(vr[d]); }
    ls = wave_sum(ls); float mine = 0.f;
    _Pragma("unroll") for (int d = 0; d < 64; ++d) { const float a0 = wave_sum(acc[d]); if (d == lane) mine = a0 / ls; }
    const long prow = pg8::perm_row((int)row, lg);
    const float got = bf2f(R1[(size_t)(T_CQ + g) * TILE_E + prow * 256 + h * 64 + lane]);
    float e = fabsf(got - mine) / (0.02f + 0.03f * fabsf(mine));
    rms_acc(errw, 16, got, mine);
    const float lse = mx + log2f(ls), glse = ((const float*)(a.ws + WS_LSE))[((size_t)g * M + prow) * 4 + h];
    e = fmaxf(e, fabsf(lse - glse) / 0.05f);
    for (int o = 1; o < 64; o <<= 1) e = fmaxf(e, __shfl_xor(e, o));
    if (lane == 0) err_max(errw, 16, e);
}
__global__ void __launch_bounds__(256) chk_attn_d(Args a, int l, float* scratch) {
    unsigned* errw = (unsigned*)(a.ws + WS_CTL) + CW_ERR;
    const bf16_t* R1 = (const bf16_t*)(a.ws + WS_R1); const bf16_t* OB = (const bf16_t*)(a.ws + WS_OBUF);
    const bf16_t* misc = R1 + (size_t)T_MISC * TILE_E;
    const int tid = threadIdx.x; const unsigned hs = hash_u32(blockIdx.x * 2654435761u + 4242u);
    const int b = hs & 3; int t = (hs >> 2) & (SEQ - 1); if (blockIdx.x < 8) t = blockIdx.x * 97 + (blockIdx.x == 7 ? 7000 : 0); if (blockIdx.x == 8) t = 255; if (blockIdx.x == 9) t = 256; if (blockIdx.x == 10) t = SEQ - 1;
    const long row = (long)b * SEQ + t; const float* rel = a.in[IN_REL];
    unsigned* keys = (unsigned*)scratch + (size_t)blockIdx.x * SEQ;
    __shared__ float iq[256]; __shared__ float iw[8]; __shared__ unsigned cnt; __shared__ int selidx[256]; __shared__ float pl[4][256]; __shared__ float red[256];
    iq[tid] = bf2f(R1[(size_t)T_IQ * TILE_E + row * 256 + tid]); if (tid < 8) iw[tid] = bf2f(misc[row * 256 + 160 + tid]);
    __syncthreads();
    for (int k = tid; k <= t; k += 256) { const bf16_t* kr = misc + ((long)b * SEQ + k) * 256 + 128; float sc = 0.f;
        for (int h = 0; h < 8; ++h) { float s = 0.f; for (int d = 0; d < 32; ++d) s += iq[h * 32 + d] * bf2f(kr[d]); sc += fmaxf(s, 0.f) * iw[h]; }
        keys[k] = dsel::okey(sc); }
    __syncthreads();
    const int n = t + 1, ksel = n < 256 ? n : 256;
    unsigned T = 0u;
    if (n > 256) { for (int bit = 31; bit >= 0; --bit) { const unsigned cand = T | (1u << bit); if (tid == 0) cnt = 0u; __syncthreads();
            unsigned c = 0; for (int k = tid; k < n; k += 256) c += keys[k] >= cand ? 1u : 0u; atomicAdd(&cnt, c); __syncthreads();
            if (cnt >= 256u) T = cand; __syncthreads(); } }
    if (tid == 0) { int p = 0; int gt = 0; for (int k = 0; k < n; ++k) if (n <= 256 || keys[k] > T) { selidx[p++] = k; ++gt; }
        if (n > 256) for (int k = 0; k < n && p < 256; ++k) if (keys[k] == T) selidx[p++] = k; }
    __syncthreads();
    const bf16_t* dq = R1 + (size_t)T_DQ * TILE_E + row * 256;
    float lg4[4] = {-1e30f, -1e30f, -1e30f, -1e30f};
    if (tid < ksel) { const int k = selidx[tid]; const bf16_t* kr = misc + ((long)b * SEQ + k) * 256;
        for (int h = 0; h < 4; ++h) { float s = 0.f; for (int d = 0; d < 64; ++d) s += bf2f(dq[h * 64 + d]) * bf2f(kr[d]); lg4[h] = s + bias2(rel, t - k, 20 + h); } }
    float den[4];
    for (int h = 0; h < 4; ++h) { red[tid] = lg4[h]; __syncthreads(); for (int o = 128; o > 0; o >>= 1) { if (tid < o) red[tid] = fmaxf(red[tid], red[tid + o]); __syncthreads(); } const float mxv = red[0]; __syncthreads();
        const float p = tid < ksel ? exp2f(lg4[h] - mxv) : 0.f; pl[h][tid] = p; red[tid] = p; __syncthreads(); for (int o = 128; o > 0; o >>= 1) { if (tid < o) red[tid] += red[tid + o]; __syncthreads(); } den[h] = red[0]; __syncthreads(); }
    const int h = tid >> 6, d = tid & 63; float o = 0.f;
    for (int i = 0; i < ksel; ++i) o += pl[h][i] * bf2f(misc[((long)b * SEQ + selidx[i]) * 256 + 64 + d]);
    o /= den[h];
    const float got = bf2f(OB[row * 1024 + 768 + h * 64 + d]);
    rms_acc(errw, 17, got, o);
    red[tid] = (got - o) * (got - o); __syncthreads(); for (int s = 128; s > 0; s >>= 1) { if (tid < s) red[tid] += red[tid + s]; __syncthreads(); } const float num = red[0]; __syncthreads();
    red[tid] = o * o; __syncthreads(); for (int s = 128; s > 0; s >>= 1) { if (tid < s) red[tid] += red[tid + s]; __syncthreads(); }
    if (tid == 0) err_max(errw, 17, sqrtf(num) / (sqrtf(red[0]) + 0.02f) / 0.05f);
}

__global__ void chk_combine(Args a) {
    unsigned* errw = (unsigned*)(a.ws + WS_CTL) + CW_ERR; const bf16_t* R1 = (const bf16_t*)(a.ws + WS_R1);
    const int s = blockIdx.x * blockDim.x + threadIdx.x; if (s >= 4096) return;
    const unsigned hs = hash_u32(s * 7919u + 555u); const int m = hs % M, c = (hs >> 15) & 255, h = c >> 6;
    float ls[3], ov[3]; for (int g = 0; g < 3; ++g) { const size_t pr = (size_t)pg8::perm_row(m, 2 * g); ls[g] = ((const float*)(a.ws + WS_LSE))[((size_t)g * M + pr) * 4 + h]; ov[g] = bf2f(R1[(size_t)(T_CQ + g) * TILE_E + pr * 256 + c]); }
    const float mx = fmaxf(fmaxf(ls[0], ls[1]), ls[2]); float ws = 0.f, o = 0.f; for (int g = 0; g < 3; ++g) { const float w = exp2f(ls[g] - mx); ws += w; o += w * ov[g]; } o /= ws;
    const float got = bf2f(((const bf16_t*)(a.ws + WS_OBUF))[(size_t)m * 1024 + 512 + c]);
    rms_acc(errw, 21, got, o); err_max(errw, 21, fabsf(got - o) / (0.01f + 0.02f * fabsf(o)));
}
__global__ void chk_merge(Args a, int l) {
    unsigned* errw = (unsigned*)(a.ws + WS_CTL) + CW_ERR; const bf16_t* R1 = (const bf16_t*)(a.ws + WS_R1); const bf16_t* OB = (const bf16_t*)(a.ws + WS_OBUF);
    const int s = blockIdx.x * (blockDim.x >> 6) + (threadIdx.x >> 6), lane = threadIdx.x & 63; if (s >= 1024) return;
    const unsigned hs = hash_u32(s * 104729u + 999u); const int m = hs % M, c = (hs >> 15) & 1023;
    float r = 0.f;
    for (int i = 0; i < 4; ++i) { float p = 0.f; for (int k = lane; k < 256; k += 64) p += bf2f(OB[(size_t)m * 1024 + i * 256 + k]) * a.in[IN_WBRANCH][(((size_t)l * 4 + i) * 256 + k) * D + c];
        p = wave_sum(p); r += bf2f(R1[(size_t)(i * 4 + (c >> 8)) * TILE_E + (size_t)m * 256 + (c & 255)]) * p; }
    const float got = bf2f(((const bf16_t*)(a.ws + WS_UBUF))[(size_t)m * D + c]);
    if (lane == 0) { rms_acc(errw, 22, got, r); err_max(errw, 22, fabsf(got - r) / (0.03f + 0.03f * fabsf(r))); }
}
__global__ void chk_outproj(Args a, int l) {
    unsigned* errw = (unsigned*)(a.ws + WS_CTL) + CW_ERR;
    const int s = blockIdx.x * (blockDim.x >> 6) + (threadIdx.x >> 6), lane = threadIdx.x & 63; if (s >= 1024) return;
    const unsigned hs = hash_u32(s * 104729u + 1234u); const int m = hs % M, c = (hs >> 15) & 1023;
    float r = 0.f; for (int k = lane; k < D; k += 64) r += bf2f(((const bf16_t*)(a.ws + WS_UBUF))[(size_t)m * D + k]) * a.in[IN_WOUT][((size_t)l * D + k) * D + c];
    r = wave_sum(r);
    const float got = bf2f(((const bf16_t*)(a.ws + WS_OBUF))[(size_t)m * D + c]);
    if (lane == 0) { rms_acc(errw, 23, got, r); err_max(errw, 23, fabsf(got - r) / (0.02f + 0.02f * fabsf(r))); }
}
__global__ void __launch_bounds__(64) chk_ln1(Args a, int l, const float* xin) {
    unsigned* errw = (unsigned*)(a.ws + WS_CTL) + CW_ERR;
    const int lane = threadIdx.x; const unsigned hs = hash_u32(blockIdx.x * 2654435761u + 31337u); const int m = hs % M, b = m >> 13;
    const float* mb = (const float*)(a.ws + WS_MOD) + ((size_t)l * 4 + b) * 6144;
    float z[16]; float s = 0.f;
    _Pragma("unroll") for (int j = 0; j < 16; ++j) { const int c = lane + 64 * j; z[j] = ALPHA * xin[(size_t)m * D + c] + (1.f + mb[2 * D + c]) * bf2f(((const bf16_t*)(a.ws + WS_OBUF))[(size_t)m * D + c]); s += z[j]; }
    const float mean = wave_sum(s) / D; float s2 = 0.f; _Pragma("unroll") for (int j = 0; j < 16; ++j) { z[j] -= mean; s2 += z[j] * z[j]; }
    const float rstd = rsqrtf(wave_sum(s2) / D + LN_EPS);
    float e = 0.f; float lg[16]; _Pragma("unroll") for (int k = 0; k < 16; ++k) lg[k] = 0.f;
    _Pragma("unroll") for (int j = 0; j < 16; ++j) { const int c = lane + 64 * j; const float x1 = z[j] * rstd * a.in[IN_LN1G][l * D + c] + a.in[IN_LN1B][l * D + c]; const float v = x1 * (1.f + mb[4 * D + c]) + mb[3 * D + c];
        e = fmaxf(e, fabsf(a.out[(size_t)m * D + c] - x1) / (1e-3f + 1e-3f * fabsf(x1)));
        e = fmaxf(e, fabsf(bf2f(((const bf16_t*)(a.ws + WS_UBUF))[(size_t)m * D + c]) - v) / (0.01f + 0.01f * fabsf(v)));
        _Pragma("unroll") for (int k = 0; k < 16; ++k) lg[k] += v * a.in[IN_WROUTER][c * 16 + k]; }
    for (int o = 1; o < 64; o <<= 1) e = fmaxf(e, __shfl_xor(e, o));
    if (lane == 0) err_max(errw, 24, e);
    float mx = -1e30f; _Pragma("unroll") for (int k = 0; k < 16; ++k) { lg[k] = wave_sum(lg[k]); mx = fmaxf(mx, lg[k]); }
    float pr[16], sl[16], ps = 0.f; _Pragma("unroll") for (int k = 0; k < 16; ++k) { pr[k] = expf(lg[k] - mx); ps += pr[k]; } _Pragma("unroll") for (int k = 0; k < 16; ++k) { pr[k] /= ps; sl[k] = pr[k] + a.in[IN_BROUTER][k]; }
    int bg = 0; float bgs = -1e30f; float gap = 1e30f;
    _Pragma("unroll") for (int g = 0; g < 4; ++g) { float t4[4]; _Pragma("unroll") for (int k = 0; k < 4; ++k) t4[k] = sl[4 * g + k]; for (int i = 0; i < 3; ++i) for (int k = 0; k < 3 - i; ++k) if (t4[k] < t4[k + 1]) { const float t = t4[k]; t4[k] = t4[k + 1]; t4[k + 1] = t; }
        const float gs = t4[0] + t4[1]; if (gs > bgs) { gap = gs - bgs; bgs = gs; bg = g; } else gap = fminf(gap, bgs - gs); }
    int e0 = -1, e1 = -1; _Pragma("unroll") for (int k = 0; k < 4; ++k) { const int ee = 4 * bg + k; if (e0 < 0 || sl[ee] > sl[e0]) { e1 = e0; e0 = ee; } else if (e1 < 0 || sl[ee] > sl[e1]) e1 = ee; }
    const float w0 = pr[e0] / (pr[e0] + pr[e1]);
    const unsigned* liste = (const unsigned*)(a.ws + WS_LISTE); const float* listw = (const float*)(a.ws + WS_LISTW); const unsigned* ctl = (const unsigned*)(a.ws + WS_CTL);
    float found = 0.f;
    for (int which = 0; which < 2; ++which) { const int ee = which ? e1 : e0; const unsigned n = ctl[CW_ECNT + 1024 * l + 64 * ee]; bool f = false; float wv = 0.f;
        for (unsigned i = lane; i < n && i < 32768u; i += 64) if ((liste[(size_t)ee * 32768 + i] >> 1) == (unsigned)m) { f = true; wv = listw[(size_t)ee * 32768 + i]; }
        const unsigned long long bm = __ballot(f); if (bm) { const int src = (int)__builtin_ctzll(bm); wv = __shfl(wv, src); const float want = which ? 1.f - w0 : w0; if (fabsf(wv - want) < 0.01f) found += 1.f; } }
    if (lane == 0 && gap > 0.02f) err_max(errw, 28, found >= 1.5f ? 0.f : 100.f);
}
__global__ void chk_moe(Args a, int l) {
    unsigned* errw = (unsigned*)(a.ws + WS_CTL) + CW_ERR; const unsigned* ctl = (const unsigned*)(a.ws + WS_CTL);
    const int s = blockIdx.x * (blockDim.x >> 6) + (threadIdx.x >> 6), lane = threadIdx.x & 63; if (s >= 512) return;
    const unsigned hs = hash_u32(s * 104729u + 4321u); const int e = hs & 15;
    int pre = 0, ce = 0; for (int k = 0; k < 16; ++k) { int c = (int)ctl[CW_ECNT + 1024 * l + 64 * k]; c = c > 32768 ? 32768 : c; if (k < e) pre += (c + 255) >> 8; if (k == e) ce = c; }
    if (ce == 0) return;
    int slot = (int)((hs >> 4) % (unsigned)ce); if (s < 16) slot = ce - 1;
    const unsigned ent = ((const unsigned*)(a.ws + WS_LISTE))[(size_t)e * 32768 + slot]; const int tok = ent >> 1; const float wgt = ((const float*)(a.ws + WS_LISTW))[(size_t)e * 32768 + slot];
    const bf16_t* v = (const bf16_t*)(a.ws + WS_UBUF) + (size_t)tok * D; const bf16_t* H = (const bf16_t*)(a.ws + WS_R1 + R1_H) + ((size_t)pre * 256 + slot) * 256;
    const int col = (hs >> 20) & 255;
    float g = 0.f, u = 0.f; for (int k = lane; k < D; k += 64) { const float vv = bf2f(v[k]); g += vv * a.in[IN_WEG][(((size_t)l * 16 + e) * D + k) * FFE + col]; u += vv * a.in[IN_WEU][(((size_t)l * 16 + e) * D + k) * FFE + col]; }
    g = wave_sum(g); u = wave_sum(u); const float hr = g / (1.f + expf(-g)) * u;
    if (lane == 0) { rms_acc(errw, 25, bf2f(H[col]), hr); err_max(errw, 25, fabsf(bf2f(H[col]) - hr) / (0.03f + 0.03f * fabsf(hr))); }
    const int oc = (hs >> 12) & 1023; float y = 0.f; for (int j = lane; j < FFE; j += 64) y += bf2f(H[j]) * a.in[IN_WED][(((size_t)l * 16 + e) * FFE + j) * D + oc];
    y = wave_sum(y) * wgt;
    const bf16_t* Y = (const bf16_t*)(a.ws + WS_R1 + ((ent & 1u) ? R1_Y1 : R1_Y0));
    if (lane == 0) { rms_acc(errw, 26, bf2f(Y[(size_t)tok * D + oc]), y); err_max(errw, 26, fabsf(bf2f(Y[(size_t)tok * D + oc]) - y) / (0.02f + 0.03f * fabsf(y))); }
}

__global__ void chk_lists_zero(unsigned* cnt) { const int i = blockIdx.x * blockDim.x + threadIdx.x; if (i < M) cnt[i] = 0u; }
__global__ void chk_lists_fill(Args a, int l, unsigned* cnt) {
    const unsigned* ctl = (const unsigned*)(a.ws + WS_CTL); const int e = blockIdx.y; const unsigned n = ctl[CW_ECNT + 1024 * l + 64 * e];
    for (unsigned i = blockIdx.x * blockDim.x + threadIdx.x; i < n && i < 32768u; i += gridDim.x * blockDim.x) { const unsigned ent = ((const unsigned*)(a.ws + WS_LISTE))[(size_t)e * 32768 + i]; if ((ent >> 1) < (unsigned)M) atomicAdd(cnt + (ent >> 1), (ent & 1u) ? 256u : 1u); else atomicAdd((unsigned*)(a.ws + WS_CTL) + CW_ERR + 29, 0x7f000000u); }
}
__global__ void chk_lists_verify(Args a, const unsigned* cnt) { unsigned* errw = (unsigned*)(a.ws + WS_CTL) + CW_ERR; const int i = blockIdx.x * blockDim.x + threadIdx.x; if (i < M && cnt[i] != 257u) err_max(errw, 29, 100.f); }
__global__ void __launch_bounds__(64) ln2_save(Args a, float* save) { const unsigned hs = hash_u32(blockIdx.x * 2654435761u + 60606u); const int m = hs % M; for (int c = threadIdx.x; c < D; c += 64) save[(size_t)blockIdx.x * D + c] = a.out[(size_t)m * D + c]; }
__global__ void __launch_bounds__(64) chk_ln2(Args a, int l, const float* save) {
    unsigned* errw = (unsigned*)(a.ws + WS_CTL) + CW_ERR;
    const int lane = threadIdx.x; const unsigned hs = hash_u32(blockIdx.x * 2654435761u + 60606u); const int m = hs % M, b = m >> 13;
    const float* mb = (const float*)(a.ws + WS_MOD) + ((size_t)l * 4 + b) * 6144;
    const bf16_t* y0 = (const bf16_t*)(a.ws + WS_R1 + R1_Y0); const bf16_t* y1 = (const bf16_t*)(a.ws + WS_R1 + R1_Y1);
    float z[16]; float s = 0.f;
#pragma unroll
    for (int j = 0; j < 16; ++j) { const int c = lane + 64 * j; z[j] = ALPHA * save[(size_t)blockIdx.x * D + c] + (1.f + mb[5 * D + c]) * (bf2f(y0[(size_t)m * D + c]) + bf2f(y1[(size_t)m * D + c])); s += z[j]; }
    const float mean = wave_sum(s) / D; float s2 = 0.f;
#pragma unroll
    for (int j = 0; j < 16; ++j) { z[j] -= mean; s2 += z[j] * z[j]; }
    const float rstd = rsqrtf(wave_sum(s2) / D + LN_EPS); float e = 0.f;
#pragma unroll
    for (int j = 0; j < 16; ++j) { const int c = lane + 64 * j; const float x2 = z[j] * rstd * a.in[IN_LN2G][l * D + c] + a.in[IN_LN2B][l * D + c];
        e = fmaxf(e, fabsf(a.out[(size_t)m * D + c] - x2) / (1e-3f + 1e-3f * fabsf(x2)));
        if (l + 1 < DEPTH) { const float* mn = mb + 4 * 6144; const float u = x2 * (1.f + mn[D + c]) + mn[c]; e = fmaxf(e, fabsf(bf2f(((const bf16_t*)(a.ws + WS_UBUF))[(size_t)m * D + c]) - u) / (0.01f + 0.01f * fabsf(u))); } }
    for (int o = 1; o < 64; o <<= 1) e = fmaxf(e, __shfl_xor(e, o));
    if (lane == 0) err_max(errw, 27, e);
}
__global__ void report(Args a, int complete) {
    const unsigned* errw = (const unsigned*)(a.ws + WS_CTL) + CW_ERR;
    __shared__ float val, val2; __shared__ int doit;
    if (threadIdx.x == 0) {
        doit = 0; val = 0.f; val2 = 0.f;
        const unsigned* ctl = (const unsigned*)(a.ws + WS_CTL);
        int id = 0; float e = 0.f;
        for (int i = 10; i < 64; ++i) { const float ei = __uint_as_float(errw[i]); if (ei > 1.0f) { id = i; e = ei; break; } }
        if (ctl[CW_TMO] != 0u || ctl[CW_BAR + XB_TMO] != 0u) { id = 99; e = 1.f; }
#ifdef PROBE_A
        { const float* ef = (const float*)errw + 64; const float ra = sqrtf(ef[2 * PROBE_A] / (ef[2 * PROBE_A + 1] + 1e-30f)), rb = sqrtf(ef[2 * PROBE_B] / (ef[2 * PROBE_B + 1] + 1e-30f));
          doit = 1; val = sqrtf(1e7f * fmaxf(ra, 1e-4f)); val2 = 1e7f * fmaxf(rb, 1e-4f); id = 0; }
#endif
        if (doit) {} else if (id) { int cls = 0; float t = e; while (t > 10.f && cls < 6) { t *= 0.1f; ++cls; } doit = 1; val = sqrtf((float)id * powf(10.f, 2.f + cls)); }
        else if (!complete) { doit = 1; val = sqrtf(10.f * 100.f); }
    }
    __syncthreads();
    if (doit && val2 != 0.f && blockIdx.x == 0 && threadIdx.x == 0) a.out[7] = val2;
    if (doit) { const float v = val; for (size_t i = (size_t)blockIdx.x * blockDim.x + threadIdx.x; i < (size_t)M * D; i += (size_t)gridDim.x * blockDim.x) if (!(i == 7 && val2 != 0.f)) a.out[i] = v; }
}
#endif

extern "C" void kernel_launch(void* const* d_in, const int* in_sizes, int n_in, void* d_out, int out_size, void* d_ws, size_t ws_size, hipStream_t stream) {
    static int grid = 0;
    if (grid == 0) {
        if (n_in != 21 || out_size != M * D || ws_size < WS_END) { fprintf(stderr, "kernel_launch: unexpected shapes (n_in %d out %d ws %zu)\n", n_in, out_size, ws_size); grid = -1; return; }
        int dev = 0, cus = 0, per_cu = 0;
        if (hipGetDevice(&dev) != hipSuccess || hipDeviceGetAttribute(&cus, hipDeviceAttributeMultiprocessorCount, dev) != hipSuccess) { grid = -1; return; }
        if (hipFuncSetAttribute((const void*)fwd_kernel, hipFuncAttributeMaxDynamicSharedMemorySize, LDS_BYTES) != hipSuccess) { fprintf(stderr, "kernel_launch: hipFuncSetAttribute failed\n"); grid = -1; return; }
        if (hipOccupancyMaxActiveBlocksPerMultiprocessor(&per_cu, (const void*)fwd_kernel, NTHREADS, LDS_BYTES) != hipSuccess || per_cu < 1) { fprintf(stderr, "kernel_launch: occupancy query says %d\n", per_cu); }
        (void)hipGetLastError();
        grid = cus;
    }
    if (grid < 0) return;
    (void)hipMemsetAsync((char*)d_ws + WS_CTL, 0, CTL_ZERO_BYTES, stream);
    Args a{};
    for (int i = 0; i < 21; ++i) a.in[i] = (const float*)d_in[i];
    a.out = (float*)d_out; a.ws = (unsigned char*)d_ws;
#if DBG
    for (int p = 0; p < N_PHASES; ++p) {
        if (p == 1 + PPL) continue;
        a.ph_lo = p; a.ph_hi = p + 1;
        float* lnsave = (float*)((char*)d_ws + WS_LSE); unsigned* tcnt = (unsigned*)((char*)d_ws + WS_LSE + 512 * 1024);
        if (p == 11 || p == 11 + PPL) hipLaunchKernelGGL(ln2_save, dim3(64), dim3(64), 0, stream, a, lnsave);
        hipLaunchKernelGGL(fwd_kernel, dim3(grid), dim3(NTHREADS), LDS_BYTES, stream, a);
        if (p == 11 || p == 11 + PPL) hipLaunchKernelGGL(chk_ln2, dim3(64), dim3(64), 0, stream, a, p == 11 ? 0 : 1, lnsave);
        if (p == 8 || p == 8 + PPL) { hipLaunchKernelGGL(chk_lists_zero, dim3(M / 256), dim3(256), 0, stream, tcnt); hipLaunchKernelGGL(chk_lists_fill, dim3(32, 16), dim3(256), 0, stream, a, p == 8 ? 0 : 1, tcnt); hipLaunchKernelGGL(chk_lists_verify, dim3(M / 256), dim3(256), 0, stream, a, tcnt); }
        if (p == 0) { hipLaunchKernelGGL(chk_mod, dim3(2), dim3(256), 0, stream, a, 0); hipLaunchKernelGGL(chk_mod, dim3(2), dim3(256), 0, stream, a, 1); }
        if (p == 1) hipLaunchKernelGGL(chk_u, dim3(16), dim3(256), 0, stream, a, 0, a.in[IN_X]);
        if (p == 2) hipLaunchKernelGGL(chk_inproj, dim3(512), dim3(256), 0, stream, a, 0, 0);
        if (p == 3) { hipLaunchKernelGGL(chk_attn_ab<0>, dim3(64), dim3(64), 0, stream, a, 0); hipLaunchKernelGGL(chk_attn_ab<1>, dim3(64), dim3(64), 0, stream, a, 0);
                      hipLaunchKernelGGL(chk_attn_c, dim3(96), dim3(64), 0, stream, a, 0); hipLaunchKernelGGL(chk_attn_d, dim3(48), dim3(256), 0, stream, a, 0, (float*)d_out); }
        if (p == 4) hipLaunchKernelGGL(chk_combine, dim3(16), dim3(256), 0, stream, a);
        if (p == 5) hipLaunchKernelGGL(chk_inproj, dim3(512), dim3(256), 0, stream, a, 0, 1);
        if (p == 6) hipLaunchKernelGGL(chk_merge, dim3(256), dim3(256), 0, stream, a, 0);
        if (p == 7) hipLaunchKernelGGL(chk_outproj, dim3(256), dim3(256), 0, stream, a, 0);
        if (p == 8) hipLaunchKernelGGL(chk_ln1, dim3(128), dim3(64), 0, stream, a, 0, a.in[IN_X]);
        if (p == 10) hipLaunchKernelGGL(chk_moe, dim3(128), dim3(256), 0, stream, a, 0);
        if (p == 1 + PPL + 10) hipLaunchKernelGGL(chk_moe, dim3(128), dim3(256), 0, stream, a, 1);
        const int q1 = p - PPL;
        if (q1 == 2) hipLaunchKernelGGL(chk_inproj, dim3(512), dim3(256), 0, stream, a, 1, 0);
        if (q1 == 3) { hipLaunchKernelGGL(chk_attn_ab<0>, dim3(64), dim3(64), 0, stream, a, 1); hipLaunchKernelGGL(chk_attn_ab<1>, dim3(64), dim3(64), 0, stream, a, 1);
                       hipLaunchKernelGGL(chk_attn_c, dim3(96), dim3(64), 0, stream, a, 1); }
        if (q1 == 4) hipLaunchKernelGGL(chk_combine, dim3(16), dim3(256), 0, stream, a);
        if (q1 == 5) hipLaunchKernelGGL(chk_inproj, dim3(512), dim3(256), 0, stream, a, 1, 1);
        if (q1 == 6) hipLaunchKernelGGL(chk_merge, dim3(256), dim3(256), 0, stream, a, 1);
        if (q1 == 7) hipLaunchKernelGGL(chk_outproj, dim3(256), dim3(256), 0, stream, a, 1);
    }
    hipLaunchKernelGGL(report, dim3(1024), dim3(256), 0, stream, a, 1);
#else
    a.ph_lo = 0; a.ph_hi = N_PHASES;
    hipLaunchKernelGGL(fwd_kernel, dim3(grid), dim3(NTHREADS), LDS_BYTES, stream, a);
#endif
}
```
